# Optimizing an MI355X kernel written in HIP

```python
import jax, jax.numpy as jnp
from jax import lax
import numpy as np

D_MODEL = 2048
BATCH = 4
SEQ = 2048
DEPTH = 1

HEAD_DIM = 64
ATTN_SCALE = HEAD_DIM ** -0.5
SWA_Q_HEADS = 16
SWA_KV_HEADS = 2
SWA_WINDOW = 128
SWA_BLOCK = 128
MOBA_HEADS = 16
MOBA_BLOCK = 256
MOBA_TOPK = 3
MOBA_Q_CHUNK = 16
N_GROUPS = 4
EXPERTS_PER_GROUP = 4
N_EXPERTS = N_GROUPS * EXPERTS_PER_GROUP
D_EXPERT = 512
TOPK_IN_GROUP = 2
EPS = 1e-6

SWA_Q_DIM = SWA_Q_HEADS * HEAD_DIM
SWA_KV_DIM = SWA_KV_HEADS * HEAD_DIM
MOBA_DIM = MOBA_HEADS * HEAD_DIM
IN_COLS = SWA_Q_DIM + 2 * SWA_KV_DIM + 3 * MOBA_DIM + 2 * D_MODEL

kernel_name = "hybrid_swa_moba_hier_moe"


def rms_norm(x, g):
    xf = x.astype(jnp.float32)
    y = xf * lax.rsqrt(jnp.mean(xf * xf, axis=-1, keepdims=True) + EPS)
    return (y * g.astype(jnp.float32)).astype(x.dtype)


def alibi_slopes(n):
    return jnp.exp2(-8.0 * jnp.arange(1, n + 1, dtype=jnp.float32) / n)


def swa_attention(q, k, v, sinks):
    B, S, Hq, dh = q.shape
    Hkv = k.shape[2]
    G = Hq // Hkv
    L = SWA_BLOCK
    nb = S // L
    qb = q.reshape(B, nb, L, Hkv, G, dh)
    kb = k.reshape(B, nb, L, Hkv, dh)
    vb = v.reshape(B, nb, L, Hkv, dh)
    zero = jnp.zeros_like(kb[:, :1])
    kw = jnp.concatenate([jnp.concatenate([zero, kb[:, :-1]], 1), kb], 2)
    vw = jnp.concatenate([jnp.concatenate([zero, vb[:, :-1]], 1), vb], 2)
    logits = jnp.einsum('bnqhgd,bnkhd->bnhgqk', qb, kw).astype(jnp.float32) * ATTN_SCALE
    qpos = jnp.arange(L)[:, None] + L
    kpos = jnp.arange(2 * L)[None, :]
    dist = qpos - kpos
    blk_ok = (jnp.arange(nb)[:, None, None] > 0) | (kpos[None] >= L)
    mask = (dist >= 0) & (dist < SWA_WINDOW) & blk_ok
    slopes = alibi_slopes(Hq).reshape(Hkv, G)[:, :, None, None]
    logits = logits - slopes * dist.astype(jnp.float32)
    logits = jnp.where(mask[None, :, None, None], logits, -jnp.inf)
    sink = jnp.broadcast_to(sinks.astype(jnp.float32).reshape(Hkv, G)[None, None, :, :, None, None],
                            logits.shape[:-1] + (1,))
    p = jax.nn.softmax(jnp.concatenate([logits, sink], -1), axis=-1)[..., :-1]
    out = jnp.einsum('bnhgqk,bnkhd->bnqhgd', p.astype(v.dtype), vw)
    return out.reshape(B, S, Hq, dh)


def moba_attention(q, k, v):
    B, S, H, dh = q.shape
    L = MOBA_BLOCK
    C = MOBA_Q_CHUNK
    nb = -(-S // L)
    Sp = nb * L
    padw = ((0, 0), (0, Sp - S), (0, 0), (0, 0))
    q, k, v = [jnp.pad(t, padw).transpose(0, 2, 1, 3) for t in (q, k, v)]
    kb = k.reshape(B, H, nb, L, dh)
    vb = v.reshape(B, H, nb, L, dh)
    t_blk = jnp.arange(Sp) // L
    slopes = alibi_slopes(H)[None, :, None, None]
    topk = min(MOBA_TOPK, nb - 1)
    if topk > 0:
        k_mean = jnp.mean(kb.astype(jnp.float32), axis=3)
        gate = jnp.einsum('bhtd,bhnd->bhtn', q.astype(jnp.float32), k_mean)
        past = jnp.arange(nb)[None, :] < t_blk[:, None]
        gate = jnp.where(past, gate, -jnp.inf)
        _, g_idx = lax.top_k(gate, topk)
        sel_ok = jnp.arange(topk)[None, :] < t_blk[:, None]
    gather = jax.vmap(jax.vmap(lambda blocks, ix: blocks[ix]))

    def chunk(c):
        start = c * C
        qc = lax.dynamic_slice_in_dim(q, start, C, axis=2)
        tq = start + jnp.arange(C)
        own = start // L
        k_own = lax.dynamic_index_in_dim(kb, own, axis=2, keepdims=False)
        v_own = lax.dynamic_index_in_dim(vb, own, axis=2, keepdims=False)
        d_own = (tq[:, None] - (own * L + jnp.arange(L))[None, :])
        lo = jnp.einsum('bhcd,bhkd->bhck', qc, k_own).astype(jnp.float32) * ATTN_SCALE
        lo = jnp.where(d_own >= 0, lo - slopes * d_own.astype(jnp.float32), -jnp.inf)
        if topk > 0:
            idx_c = lax.dynamic_slice_in_dim(g_idx, start, C, axis=2)
            ok_c = lax.dynamic_slice_in_dim(sel_ok, start, C, axis=0)
            kg = gather(kb, idx_c)
            vg = gather(vb, idx_c)
            d_g = tq[:, None, None] - (idx_c[..., None] * L + jnp.arange(L))
            lg = jnp.einsum('bhcd,bhcjkd->bhcjk', qc, kg).astype(jnp.float32) * ATTN_SCALE
            lg = lg - slopes[..., None] * d_g.astype(jnp.float32)
            lg = jnp.where(ok_c[:, :, None], lg, -jnp.inf).reshape(B, H, C, topk * L)
            p = jax.nn.softmax(jnp.concatenate([lg, lo], -1), axis=-1).astype(v.dtype)
            pg = p[..., :topk * L].reshape(B, H, C, topk, L)
            po = p[..., topk * L:]
            return (jnp.einsum('bhcjk,bhcjkd->bhcd', pg, vg)
                    + jnp.einsum('bhck,bhkd->bhcd', po, v_own))
        po = jax.nn.softmax(lo, axis=-1).astype(v.dtype)
        return jnp.einsum('bhck,bhkd->bhcd', po, v_own)

    outs = lax.map(chunk, jnp.arange(Sp // C))
    out = outs.transpose(1, 2, 0, 3, 4).reshape(B, H, Sp, dh)[:, :, :S]
    return out.transpose(0, 2, 1, 3)


def hierarchical_moe(h, w_router_group, w_router_expert, w_gate_e, w_up_e, w_down_e):
    B, S, D = h.shape
    t = h.reshape(B * S, D)
    grp_prob = jax.nn.softmax((t @ w_router_group).astype(jnp.float32), axis=-1)
    g_p, g_i = lax.top_k(grp_prob, 1)
    exp_logits = jnp.einsum('td,gde->tge', t, w_router_expert).astype(jnp.float32)
    sel_logits = jnp.take_along_axis(exp_logits, g_i[:, :, None], axis=1)[:, 0]
    e_p, e_i = lax.top_k(jax.nn.softmax(sel_logits, axis=-1), TOPK_IN_GROUP)
    w = g_p * (e_p / jnp.sum(e_p, axis=-1, keepdims=True))
    expert_id = g_i * EXPERTS_PER_GROUP + e_i
    combine = jnp.sum(jax.nn.one_hot(expert_id, N_EXPERTS, dtype=jnp.float32) * w[..., None], axis=1)
    hid = jax.nn.silu(jnp.einsum('td,edf->tef', t, w_gate_e)) * jnp.einsum('td,edf->tef', t, w_up_e)
    out = jnp.einsum('tef,efd->td', hid * combine[:, :, None].astype(hid.dtype), w_down_e)
    return out.reshape(B, S, D)


def setup_inputs(seed: int = 0) -> dict:
    key = jax.random.key(seed)
    ks = jax.random.split(key, 20)
    nrm = lambda k, shape, fan: jax.random.normal(k, shape, jnp.float32) * fan ** -0.5
    gain = lambda k, n: 1.0 + 0.1 * jax.random.normal(k, (n,), jnp.float32)
    return {
        "x": jax.random.normal(ks[0], (BATCH, SEQ, D_MODEL), jnp.float32),
        "g_mix": gain(ks[1], D_MODEL),
        "w_in": nrm(ks[2], (D_MODEL, IN_COLS), D_MODEL),
        "q_norm_swa": gain(ks[3], HEAD_DIM),
        "k_norm_swa": gain(ks[4], HEAD_DIM),
        "sinks": jax.random.normal(ks[5], (SWA_Q_HEADS,), jnp.float32),
        "q_norm_moba": gain(ks[6], HEAD_DIM),
        "k_norm_moba": gain(ks[7], HEAD_DIM),
        "w_up_swa": nrm(ks[8], (SWA_Q_DIM, D_MODEL), SWA_Q_DIM),
        "w_up_moba": nrm(ks[9], (MOBA_DIM, D_MODEL), MOBA_DIM),
        "w_out": nrm(ks[10], (D_MODEL, D_MODEL), D_MODEL),
        "g_ffn": gain(ks[11], D_MODEL),
        "w_router_group": nrm(ks[12], (D_MODEL, N_GROUPS), D_MODEL),
        "w_router_expert": nrm(ks[13], (N_GROUPS, D_MODEL, EXPERTS_PER_GROUP), D_MODEL),
        "w_gate_e": nrm(ks[14], (N_EXPERTS, D_MODEL, D_EXPERT), D_MODEL),
        "w_up_e": nrm(ks[15], (N_EXPERTS, D_MODEL, D_EXPERT), D_MODEL),
        "w_down_e": nrm(ks[16], (N_EXPERTS, D_EXPERT, D_MODEL), D_EXPERT),
    }


def reference(x, g_mix, w_in, q_norm_swa, k_norm_swa, sinks, q_norm_moba, k_norm_moba,
              w_up_swa, w_up_moba, w_out, g_ffn, w_router_group, w_router_expert,
              w_gate_e, w_up_e, w_down_e):
    B, S, D = x.shape
    for _ in range(DEPTH):
        h = rms_norm(x, g_mix)
        proj = h @ w_in
        cuts = np.cumsum([SWA_Q_DIM, SWA_KV_DIM, SWA_KV_DIM, MOBA_DIM, MOBA_DIM, MOBA_DIM, D_MODEL]).tolist()
        qa, ka, va, qb, kb, vb, gate_a, gate_b = jnp.split(proj, cuts, axis=-1)
        qa = rms_norm(qa.reshape(B, S, SWA_Q_HEADS, HEAD_DIM), q_norm_swa)
        ka = rms_norm(ka.reshape(B, S, SWA_KV_HEADS, HEAD_DIM), k_norm_swa)
        va = va.reshape(B, S, SWA_KV_HEADS, HEAD_DIM)
        qb = rms_norm(qb.reshape(B, S, MOBA_HEADS, HEAD_DIM), q_norm_moba)
        kb = rms_norm(kb.reshape(B, S, MOBA_HEADS, HEAD_DIM), k_norm_moba)
        vb = vb.reshape(B, S, MOBA_HEADS, HEAD_DIM)
        y_a = swa_attention(qa, ka, va, sinks).reshape(B, S, SWA_Q_DIM) @ w_up_swa
        y_b = moba_attention(qb, kb, vb).reshape(B, S, MOBA_DIM) @ w_up_moba
        merged = jax.nn.sigmoid(gate_a) * y_a + jax.nn.sigmoid(gate_b) * y_b
        x = x + merged @ w_out
        h = rms_norm(x, g_ffn)
        x = x + hierarchical_moe(h, w_router_group, w_router_expert, w_gate_e, w_up_e, w_down_e)
    return x
```

```cpp
#include <hip/hip_runtime.h>
#include <cstdio>
#include <cstdint>

#ifndef MK_LAUNCHES
#define MK_LAUNCHES 1
#endif

#define LAS __attribute__((address_space(3)))
#define GAS __attribute__((address_space(1)))
typedef unsigned short bf16_t;
typedef short bf16x8 __attribute__((ext_vector_type(8)));
typedef float f32x4 __attribute__((ext_vector_type(4)));
typedef float f32x2 __attribute__((ext_vector_type(2)));
typedef unsigned u32x4 __attribute__((ext_vector_type(4)));
typedef unsigned u32x2 __attribute__((ext_vector_type(2)));
typedef GAS unsigned gu32;
#define RLX_AGENT __ATOMIC_RELAXED, __HIP_MEMORY_SCOPE_AGENT

constexpr int DM = 2048, NB = 4, SEQ = 2048, NTOK = NB * SEQ, HD = 64;
constexpr int INC = 8448;
constexpr int QA0 = 0, KA0 = 1024, VA0 = 1152, QB0 = 1280, KB0 = 2304, VB0 = 3328, GA0 = 4352, GB0 = 6400;
constexpr int NEXP = 16, DEXP = 512;
constexpr float EPS = 1e-6f;
constexpr float LOG2E = 1.4426950408889634f;
constexpr float QSCALE = 0.125f * LOG2E;
constexpr int SLOT_CAP = NTOK * 2 + NEXP * 256;

constexpr size_t MiB = 1u << 20;
constexpr size_t WS_CTL = 0, CTL_ZERO_BYTES = 64 * 1024;
constexpr size_t WS_KSUM = 1 * MiB;
constexpr size_t WS_XS = 1 * MiB + 512 * 1024;
constexpr size_t WS_WSC = 1 * MiB + 768 * 1024;
constexpr size_t WS_SS = 2 * MiB;
constexpr size_t WS_RT = 3 * MiB;
constexpr size_t RT_TOKE = 0, RT_TOKW = 64 * 1024, RT_CNT = 128 * 1024, RT_INFO = 160 * 1024, RT_TOS = 192 * 1024, RT_WOS = 320 * 1024, RT_SOT = 448 * 1024, RT_RSTD = 512 * 1024, RT_RSOS = 576 * 1024;
constexpr size_t WS_WIN = 4 * MiB;
constexpr size_t WS_WUP = 37 * MiB;
constexpr size_t WS_WOUT = 45 * MiB;
constexpr size_t WS_WGU = 53 * MiB;
constexpr size_t WS_WD = 117 * MiB;
constexpr size_t WS_XN = 149 * MiB;
constexpr size_t WS_PROJ = 181 * MiB;
constexpr size_t WS_MERGED = 4 * MiB;
constexpr size_t WS_SL = 313 * MiB;
constexpr size_t SL_TOS = 0, SL_WOS = 512 * 1024, SL_RSOS = 1024 * 1024, SL_T2S = 1536 * 1024;
constexpr size_t WS_Y2 = 4 * MiB;
constexpr int NBK = 24, BCAP = 8192;
constexpr int ECAP = 8192;
constexpr size_t WS_GWT = 3 * MiB;
constexpr size_t WS_X8 = 316 * MiB;
constexpr size_t WS_BK = 332 * MiB;
constexpr size_t BK_TOK = 0, BK_RA = 768 * 1024, BK_RB = 1536 * 1024, BK_BYTES = 2304 * 1024;
constexpr size_t WS_END = 335 * MiB;
constexpr float SX8 = 8.f, SW8 = 32.f, SH8 = 16.f, SD8 = 16.f, SXN8 = 8.f, SWI8 = 32.f, SY8 = 64.f;
constexpr int NT_QKV = GA0 / 256;
constexpr size_t WS_WIN8 = WS_WIN;

constexpr int CW_TMO = 0, CW_BAR = 1024, CW_ECNT = 6144, CW_BCNT = 6176;

constexpr int RING_BYTES = 131072;
constexpr int LDSCTL_OFF = RING_BYTES, MISC_OFF = LDSCTL_OFF + 320;
constexpr int LDS_X_OFF = RING_BYTES + 1024;
constexpr int LDS_BYTES = 147456;
constexpr int NWAVES = 8;

#define LDS_WAIT() asm volatile("s_waitcnt lgkmcnt(0)" ::: "memory")
#define VM_WAIT() asm volatile("s_waitcnt vmcnt(0)" ::: "memory")
__device__ __forceinline__ unsigned f2bf(float f) { unsigned u = __builtin_bit_cast(unsigned, f); return (u + 0x7fffu + ((u >> 16) & 1u)) >> 16; }
__device__ __forceinline__ unsigned pk2(float lo, float hi) { return f2bf(lo) | (f2bf(hi) << 16); }
__device__ __forceinline__ float bf_lo(unsigned w) { return __builtin_bit_cast(float, w << 16); }
__device__ __forceinline__ float bf_hi(unsigned w) { return __builtin_bit_cast(float, w & 0xffff0000u); }
__device__ __forceinline__ float wave_sum(float v) {
#pragma unroll
    for (int o = 1; o < 64; o <<= 1) v += __shfl_xor(v, o);
    return v;
}
typedef int i32x4 __attribute__((ext_vector_type(4)));
typedef int i32x8 __attribute__((ext_vector_type(8)));
__device__ __forceinline__ unsigned pk8(float a, float b, float c, float d) {
    int w = __builtin_amdgcn_cvt_pk_fp8_f32(a, b, 0, false); w = __builtin_amdgcn_cvt_pk_fp8_f32(c, d, w, true); return (unsigned)w; }
__device__ __forceinline__ float wave_max(float v) {
#pragma unroll
    for (int o = 1; o < 64; o <<= 1) v = fmaxf(v, __shfl_xor(v, o));
    return v;
}
__device__ __forceinline__ unsigned pki8(float a, float b, float c, float d) {
    const int ia = (int)__builtin_rintf(a), ib = (int)__builtin_rintf(b), ic = (int)__builtin_rintf(c), id = (int)__builtin_rintf(d);
    return (unsigned)(ia & 255) | ((unsigned)(ib & 255) << 8) | ((unsigned)(ic & 255) << 16) | ((unsigned)id << 24); }
__device__ __forceinline__ float amax4(float m, const f32x4& v) { return fmaxf(fmaxf(m, fmaxf(fabsf(v[0]), fabsf(v[1]))), fmaxf(fabsf(v[2]), fabsf(v[3]))); }
__device__ __forceinline__ unsigned ld_agent(const unsigned* p) { return __hip_atomic_load(p, RLX_AGENT); }
__device__ __forceinline__ float ld_agent_f(const float* p) { return __builtin_bit_cast(float, __hip_atomic_load((const unsigned*)p, RLX_AGENT)); }

namespace g8 {
constexpr int BM = 256, BK = 64, HALF = 128, HTB = HALF * BK * 2, NXCD = 8, WGM = 4;
__host__ __device__ __forceinline__ int lds_byte(int r, int c) { const int st = (r >> 4) * 2 + (c >> 5), rr = r & 15, cc = c & 31, ob = rr * 64 + cc * 2; return st * 1024 + (ob ^ (((ob >> 9) & 1) << 5)); }
__host__ __device__ __forceinline__ void stage_rc(int b, int& R, int& C) { const int st = b / 1024, sb = b % 1024, swz = sb ^ (((sb >> 9) & 1) << 5); R = (st >> 1) * 16 + swz / 64; C = (st & 1) * 32 + (swz % 64) / 2; }

struct Unit { const char* a; const char* b; const int* rows; int nkt; int pm, pn, x0, x1; };

__device__ __forceinline__ bool tile_order(int nM, int nN, int G, int c, int i, int& pm, int& pn) {
    const int nwg = nM * nN; const long L = (long)i * G + c; if (L >= nwg) return false;
    int wgid = (int)L; { const int q = nwg / NXCD, r = nwg % NXCD, xcd = wgid % NXCD, off = wgid / NXCD; wgid = (xcd < r ? xcd * (q + 1) : r * (q + 1) + (xcd - r) * q) + off; }
    const int nig = WGM * nN, gid = wgid / nig, fm = gid * WGM, gsz = (nM - fm) < WGM ? (nM - fm) : WGM;
    pm = fm + ((wgid % nig) % gsz); pn = (wgid % nig) / gsz; return true;
}

template <class Epi, class Sched, bool GATHER, bool FP8 = false, bool I8 = false>
__device__ __forceinline__ void gemm_phase(LAS unsigned char* lds, const int lda, const int ldb, const Sched& S, const Epi& E) {
    const int tid = threadIdx.x, wid = __builtin_amdgcn_readfirstlane(tid >> 6), lane = tid & 63, wr = wid >> 2, wc = wid & 3, fr = lane & 15, fq = lane >> 4;
    int Rr[2], Cc[2];
#pragma unroll
    for (int i = 0; i < 2; ++i) stage_rc(tid * 16 + i * 8192, Rr[i], Cc[i]);
    unsigned voffB[2], voffA[2];
#pragma unroll
    for (int i = 0; i < 2; ++i) { voffB[i] = (unsigned)(Rr[i] * ldb + Cc[i]) * 2u; voffA[i] = (unsigned)(Rr[i] * lda + Cc[i]) * 2u; }
    const size_t kstep = (size_t)(BK * 2);
    const size_t hstepA = (size_t)HALF * lda * 2, hstepB = (size_t)HALF * ldb * 2;
    const unsigned ldsw = (unsigned)wid * 1024u;
    const int aoff = lds_byte(wr * 64 + fr, fq * 8), boff = lds_byte(wc * 32 + fr, fq * 8);
    const int aoff8 = lds_byte(wr * 64 + fr, 16 * (fq & 1)) + (fq >> 1) * 1024, boff8 = lds_byte(wc * 32 + fr, 16 * (fq & 1)) + (fq >> 1) * 1024;
#define G8_SA(b, h) (((b) * 2 + (h)) * HTB)
#define G8_SB(b, h) ((4 + (b) * 2 + (h)) * HTB)
#define G8_STAGE(bufoff, gbase, voff) do { _Pragma("unroll") for (int _i = 0; _i < 2; ++_i) \
        __builtin_amdgcn_global_load_lds((const unsigned*)((const char*)(gbase) + (voff)[_i]), (LAS unsigned*)(lds + (bufoff) + ldsw + _i * 8192), 16, 0, 0); } while (0)
#define G8_STAGE_A(bufoff, gbase, h, va) do { if (GATHER) { G8_STAGE(bufoff, gbase, (va)[h]); } else { G8_STAGE(bufoff, (gbase) + (h) * hstepA, voffA); } } while (0)
#define G8_STAGE_B(bufoff, gbase, h) G8_STAGE(bufoff, (gbase) + (h) * hstepB, voffB)
#define G8_LD8(p) (*(const LAS i32x8*)(p))
#define G8_LDA(dst, b, h) do { _Pragma("unroll") for (int m = 0; m < 4; ++m) { if (FP8) dst##8[m] = G8_LD8(lds + G8_SA(b, h) + aoff8 + m * 2048); else { _Pragma("unroll") for (int k = 0; k < 2; ++k) dst[m][k] = *(const LAS bf16x8*)(lds + G8_SA(b, h) + aoff + m * 2048 + k * 1024); } } } while (0)
#define G8_LDB(dst, b, h) do { _Pragma("unroll") for (int n = 0; n < 2; ++n) { if (FP8) dst##8[n] = G8_LD8(lds + G8_SB(b, h) + boff8 + n * 2048); else { _Pragma("unroll") for (int k = 0; k < 2; ++k) dst[n][k] = *(const LAS bf16x8*)(lds + G8_SB(b, h) + boff + n * 2048 + k * 1024); } } } while (0)
#define G8_CAT(x0, x1) __builtin_shufflevector(__builtin_bit_cast(i32x4, x0), __builtin_bit_cast(i32x4, x1), 0, 1, 2, 3, 4, 5, 6, 7)
#define G8_MMA(ai, bj, At, Bt) do { __builtin_amdgcn_s_setprio(1); _Pragma("unroll") for (int m = 0; m < 4; ++m) _Pragma("unroll") for (int n = 0; n < 2; ++n) { \
        if (FP8) asm volatile("v_mfma_scale_f32_16x16x128_f8f6f4 %0, %1, %2, %0, %3, %3 op_sel_hi:[0,0,0]" : "+v"(acc[ai][bj][m][n]) : "v"(Bt##8[n]), "v"(At##8[m]), "v"(one8));     \
        else if (I8) { _Pragma("unroll") for (int k = 0; k < 2; ++k) acc[ai][bj][m][n] = __builtin_bit_cast(f32x4, __builtin_amdgcn_mfma_i32_16x16x64_i8(__builtin_bit_cast(i32x4, Bt[n][k]), __builtin_bit_cast(i32x4, At[m][k]), __builtin_bit_cast(i32x4, acc[ai][bj][m][n]), 0, 0, 0)); }     \
        else { _Pragma("unroll") for (int k = 0; k < 2; ++k) acc[ai][bj][m][n] = __builtin_amdgcn_mfma_f32_16x16x32_bf16(Bt[n][k], At[m][k], acc[ai][bj][m][n], 0, 0, 0); } } \
        __builtin_amdgcn_s_setprio(0); } while (0)
#define G8_WAIT_V(n) asm volatile("s_waitcnt vmcnt(" #n ")" ::: "memory")
#define G8_WAIT_L(n) asm volatile("s_waitcnt lgkmcnt(" #n ")" ::: "memory")
#define G8_BAR __builtin_amdgcn_s_barrier()
#define G8_SCHED __builtin_amdgcn_sched_barrier(0)
#define G8_AOFF(dst, u) do { int _t = tid; asm volatile("" : "+v"(_t)); _Pragma("unroll") for (int _i = 0; _i < 2; ++_i) { int _R, _C; stage_rc(_t * 16 + _i * 8192, _R, _C); \
        _Pragma("unroll") for (int _h = 0; _h < 2; ++_h) { const int _r = (int)ld_agent((const unsigned*)((u).rows + _h * HALF + _R)); dst[_h][_i] = (unsigned)(_r * lda + _C) * 2u; } } } while (0)
    Unit cur, nxt; int ui = 0;
    if (!S.next(0, cur)) return;
    unsigned cva[2][2], nva[2][2];
    if (GATHER) { G8_AOFF(cva, cur); }
    f32x4 acc[2][2][4][2];
#pragma unroll
    for (int a = 0; a < 2; ++a)
#pragma unroll
        for (int b = 0; b < 2; ++b)
#pragma unroll
            for (int m = 0; m < 4; ++m)
#pragma unroll
                for (int n = 0; n < 2; ++n) acc[a][b][m][n] = (f32x4){0.f, 0.f, 0.f, 0.f};
    bf16x8 At[4][2], B0[2][2], B1[2][2]; i32x8 At8[4], B08[2], B18[2]; const int one8 = 0x7f7f7f7f;
    const char* cA = cur.a; const char* cB = cur.b;
    G8_STAGE_B(G8_SB(0, 0), cB, 0); G8_STAGE_B(G8_SB(0, 1), cB, 1); G8_STAGE_A(G8_SA(0, 0), cA, 0, cva); G8_STAGE_A(G8_SA(0, 1), cA, 1, cva);
    if (wr == 1) G8_BAR;
    G8_WAIT_V(2); G8_BAR;
    G8_STAGE_B(G8_SB(1, 0), cB + kstep, 0); G8_STAGE_A(G8_SA(1, 0), cA + kstep, 0, cva); G8_STAGE_B(G8_SB(1, 1), cB + kstep, 1);
    G8_WAIT_V(6); G8_BAR;
    for (;;) {
        const bool has_next = S.next(ui + 1, nxt);
        const char* nA = has_next ? nxt.a : cA; const char* nB = has_next ? nxt.b : cB;
        if (GATHER) { if (has_next) { G8_AOFF(nva, nxt); } else {
#pragma unroll
            for (int h = 0; h < 2; ++h) { nva[h][0] = cva[h][0]; nva[h][1] = cva[h][1]; } } }
        const int nt = cur.nkt;
        for (int t = 0; t < nt; t += 2) {
            const bool last = (t == nt - 2);
            const char* a1 = cA + (size_t)(t + 1) * kstep;
            const char* a2 = last ? nA : cA + (size_t)(t + 2) * kstep; const char* b2 = last ? nB : cB + (size_t)(t + 2) * kstep;
            const char* a3 = a2 + kstep; const char* b3 = b2 + kstep;
            unsigned va2[2][2];
#pragma unroll
            for (int h = 0; h < 2; ++h)
#pragma unroll
                for (int i = 0; i < 2; ++i) va2[h][i] = (GATHER && last) ? nva[h][i] : cva[h][i];
            G8_LDB(B0, 0, 0); G8_LDB(B1, 0, 1); G8_SCHED; G8_LDA(At, 0, 0); G8_STAGE_A(G8_SA(1, 1), a1, 1, cva);
            G8_WAIT_V(8); G8_WAIT_L(0); G8_BAR; G8_MMA(0, 0, At, B0); G8_MMA(0, 1, At, B1); G8_BAR; G8_SCHED;
            G8_LDA(At, 0, 1); G8_STAGE_B(G8_SB(0, 0), b2, 0); G8_STAGE_B(G8_SB(0, 1), b2, 1); G8_STAGE_A(G8_SA(0, 0), a2, 0, va2);
            G8_WAIT_V(8); G8_WAIT_L(0); G8_BAR; G8_MMA(1, 0, At, B0); G8_MMA(1, 1, At, B1); G8_BAR; G8_SCHED;
            G8_LDB(B0, 1, 0); G8_LDB(B1, 1, 1); G8_SCHED; G8_LDA(At, 1, 0); G8_STAGE_A(G8_SA(0, 1), a2, 1, va2);
            G8_WAIT_V(8); G8_WAIT_L(0); G8_BAR; G8_MMA(0, 0, At, B0); G8_MMA(0, 1, At, B1); G8_BAR; G8_SCHED;
            G8_LDA(At, 1, 1); G8_STAGE_B(G8_SB(1, 0), b3, 0); G8_STAGE_B(G8_SB(1, 1), b3, 1); G8_STAGE_A(G8_SA(1, 0), a3, 0, va2);
            G8_WAIT_V(8); G8_WAIT_L(0); G8_BAR; G8_MMA(1, 0, At, B0); G8_MMA(1, 1, At, B1); G8_BAR; G8_SCHED;
        }
        if (FP8) asm volatile("s_nop 15\n\ts_nop 15" ::: "memory");
        if (wr == 0) G8_BAR;
        const bool keep = E(acc, cur, wr, wc, fr, fq);
        if (!has_next) break;
        if (!keep) {
#pragma unroll
            for (int a = 0; a < 2; ++a)
#pragma unroll
                for (int b = 0; b < 2; ++b)
#pragma unroll
                    for (int m = 0; m < 4; ++m)
#pragma unroll
                        for (int n = 0; n < 2; ++n) acc[a][b][m][n] = (f32x4){0.f, 0.f, 0.f, 0.f};
        }
        cur = nxt; cA = nA; cB = nB; ++ui;
        if (GATHER) {
#pragma unroll
            for (int h = 0; h < 2; ++h) { cva[h][0] = nva[h][0]; cva[h][1] = nva[h][1]; } }
        if (wr == 1) G8_BAR;
    }
    G8_WAIT_V(0);
    G8_BAR;
#undef G8_SA
#undef G8_SB
#undef G8_STAGE
#undef G8_STAGE_A
#undef G8_STAGE_B
#undef G8_LDA
#undef G8_LD8
#undef G8_LDB
#undef G8_MMA
#undef G8_CAT
#undef G8_WAIT_V
#undef G8_WAIT_L
#undef G8_BAR
#undef G8_SCHED
#undef G8_AOFF
}
}

#define XB_TMO      128
#define XB_XCNT(j)  (256  + 64 * (j))
#define XB_XSUB(j)  (1280 + 64 * (j))
#define XB_XGEN(j)  (2304 + 64 * (j))
#define XB_TOP      3328
#define XB_TOPGEN   3392
#define XCD_BAR_WORDS 3456
#define XB_SPIN_CAP (1u << 18)
__device__ __forceinline__ unsigned xb_ld(unsigned* p)              { return __hip_atomic_load(p, __ATOMIC_RELAXED, __HIP_MEMORY_SCOPE_AGENT); }
__device__ __forceinline__ unsigned xb_add(unsigned* p, unsigned v) { return __hip_atomic_fetch_add(p, v, __ATOMIC_RELAXED, __HIP_MEMORY_SCOPE_AGENT); }
__device__ __forceinline__ unsigned xb_xcc_id() { return (unsigned)__builtin_amdgcn_s_getreg((3 << 11) | 20) & 0xFu; }
#define XB_SPIN(cond, bar) do { unsigned _sp = 0; while (cond) { __builtin_amdgcn_s_sleep(1); \
    if ((++_sp & 255u) == 0u) { if (xb_ld(&(bar)[XB_TMO])) break; if (_sp > XB_SPIN_CAP) { atomicAdd(&(bar)[XB_TMO], 1u); break; } } } } while (0)
struct XcdBarrier { unsigned* bar; unsigned x; volatile LAS unsigned* st; };
__device__ __forceinline__ XcdBarrier xcd_barrier_post(unsigned* bar, volatile LAS unsigned* st) {
    XcdBarrier b; b.bar = bar; b.x = xb_xcc_id(); b.st = st;
    if (threadIdx.x == 0) (void)xb_add(&bar[XB_XCNT(b.x)], 1u);
    return b;
}
__device__ __forceinline__ void xcd_barrier_complete(unsigned* bar, unsigned x, unsigned& nloc, unsigned& nx) {
    const unsigned G = gridDim.x * gridDim.y * gridDim.z;
    unsigned sum, cnt, mine, sp = 0u;
    for (;;) {
        sum = 0u; cnt = 0u; mine = 0u;
#pragma unroll
        for (unsigned j = 0; j < 16; ++j) { const unsigned c = xb_ld(&bar[XB_XCNT(j)]); sum += c; cnt += (c > 0u) ? 1u : 0u; mine = (j == x) ? c : mine; }
        if (sum == G) break;
        __builtin_amdgcn_s_sleep(1);
        if ((++sp & 255u) == 0u) { if (xb_ld(&bar[XB_TMO])) break; if (sp > XB_SPIN_CAP) { atomicAdd(&bar[XB_TMO], 1u); break; } }
    }
    nloc = mine > 0u ? mine : 1u; nx = cnt > 0u ? cnt : 1u;
}
__device__ __forceinline__ void xcd_barrier(const XcdBarrier& b) {
    asm volatile("s_waitcnt vmcnt(0)" ::: "memory");
    __syncthreads();
    if (threadIdx.x == 0) {
        unsigned* bar = b.bar;
        __builtin_amdgcn_s_waitcnt(0);
        unsigned nloc = b.st[0], nx = b.st[1];
        if (nloc == 0u) { xcd_barrier_complete(bar, b.x, nloc, nx); b.st[0] = nloc; b.st[1] = nx; }
        const unsigned old = xb_add(&bar[XB_XSUB(b.x)], 1u);
        const unsigned gen = old / nloc;
        if (old + 1u == (gen + 1u) * nloc) {
            __builtin_amdgcn_fence(__ATOMIC_RELEASE, "agent");
            asm volatile("s_waitcnt vmcnt(0)" ::: "memory");
            const unsigned og = xb_add(&bar[XB_TOP], 1u);
            const unsigned tg = og / nx;
            if (og + 1u == (tg + 1u) * nx) xb_add(&bar[XB_TOPGEN], 1u);
            else XB_SPIN(xb_ld(&bar[XB_TOPGEN]) == tg, bar);
            __builtin_amdgcn_fence(__ATOMIC_ACQUIRE, "agent");
            xb_add(&bar[XB_XGEN(b.x)], 1u);
            asm volatile("s_waitcnt vmcnt(0)" ::: "memory");
        } else {
            XB_SPIN(xb_ld(&bar[XB_XGEN(b.x)]) == gen, bar);
            __builtin_amdgcn_fence(__ATOMIC_ACQUIRE, "agent");
            asm volatile("s_waitcnt vmcnt(0)" ::: "memory");
        }
    }
    __syncthreads();
}

struct Args { const float* in[17]; float* out; unsigned char* ws; int ph_lo, ph_hi; };

struct Frame {
    LAS unsigned char* lds;
    int tid, lane, wave, vcu, G;
    const float *x, *g_mix, *w_in, *qn_a, *kn_a, *sinks, *qn_b, *kn_b, *w_upa, *w_upb, *w_out, *g_ffn, *w_rg, *w_re, *w_ge, *w_ue, *w_de;
    float* out; unsigned char* ws;
};

__device__ __forceinline__ int perm_in(int j) { return 16 * ((j >> 2) & 1) + 4 * (j >> 3) + (j & 3); }

struct CvItem { const float* src; bf16_t* dst; int ldw, ldt; const float* gk; float sc8; };
__device__ __forceinline__ void cv_load(f32x4 (&v)[8], const CvItem& it, int lane) {
#pragma unroll
    for (int j = 0; j < 8; ++j) v[j] = *(const GAS f32x4*)(it.src + (size_t)((lane >> 3) + 8 * j) * it.ldw + 4 * (lane & 7));
    if (it.gk) {
#pragma unroll
        for (int j = 0; j < 8; ++j) v[j] = v[j] * it.gk[(lane >> 3) + 8 * j]; }
    if (it.sc8 != 0.f) {
#pragma unroll
        for (int j = 0; j < 8; ++j) v[j] = v[j] * it.sc8; }
}
__device__ __forceinline__ void cv_to_lds(const f32x4 (&v)[8], LAS float* scr, int lane) {
#pragma unroll
    for (int j = 0; j < 8; ++j) { LAS float* d = scr + ((lane >> 3) + 8 * j) * 33 + 4 * (lane & 7); d[0] = v[j][0]; d[1] = v[j][1]; d[2] = v[j][2]; d[3] = v[j][3]; }
}
__device__ __forceinline__ void cv_store(const CvItem& it, const LAS float* scr, int lane) {
    const int c = lane & 7;
    if (it.sc8 != 0.f) {
#pragma unroll
        for (int j = 0; j < 4; ++j) { const int n = (lane >> 3) + 8 * j; const LAS float* s = scr + (8 * c) * 33 + n;
            u32x2 o; o.x = pk8(s[0 * 33], s[1 * 33], s[2 * 33], s[3 * 33]); o.y = pk8(s[4 * 33], s[5 * 33], s[6 * 33], s[7 * 33]);
            *(GAS u32x2*)((unsigned char*)it.dst + (size_t)perm_in(n) * it.ldt + 8 * c) = o; }
        return; }
#pragma unroll
    for (int j = 0; j < 4; ++j) { const int n = (lane >> 3) + 8 * j; const LAS float* s = scr + (8 * c) * 33 + n;
        u32x4 o; o.x = pk2(s[0 * 33], s[1 * 33]); o.y = pk2(s[2 * 33], s[3 * 33]); o.z = pk2(s[4 * 33], s[5 * 33]); o.w = pk2(s[6 * 33], s[7 * 33]);
        *(GAS u32x4*)(it.dst + (size_t)perm_in(n) * it.ldt + 8 * c) = o; }
}
template <class Dec> __device__ __forceinline__ void convert_list(const Dec& dec, int gw, int NGW, int N, LAS float* scr, int lane) {
    if (gw >= N) return;
    f32x4 v[8]; CvItem cur = dec(gw); cv_load(v, cur, lane);
    for (int it = gw; it < N; it += NGW) {
        cv_to_lds(v, scr, lane);
        const int nx = it + NGW; CvItem nxt = cur; if (nx < N) { nxt = dec(nx); cv_load(v, nxt, lane); }
        LDS_WAIT(); asm volatile("" ::: "memory");
        cv_store(cur, scr, lane);
        LDS_WAIT(); asm volatile("" ::: "memory");
        cur = nxt;
    }
}
__device__ __forceinline__ int std_row0(int n0) { return (n0 & ~255) + 128 * ((n0 >> 5) & 1) + 32 * ((n0 >> 6) & 3); }

__device__ __forceinline__ void convert_w_in_i8(const Frame& F, int nb) {
    LAS float* scr = (LAS float*)(F.lds + F.wave * 16384);
    volatile LAS float* red = (volatile LAS float*)(F.lds + 12288);
    const int lane = F.lane, w = F.wave;
    const float* src = F.w_in + (size_t)(256 * w + (lane >> 3)) * INC + 32 * nb + 4 * (lane & 7);
    f32x4 v[4][8];
#pragma unroll
    for (int it = 0; it < 4; ++it)
#pragma unroll
        for (int j = 0; j < 8; ++j) v[it][j] = *(const GAS f32x4*)(src + (size_t)(64 * it + 8 * j) * INC);
    float am = 0.f;
#pragma unroll
    for (int it = 0; it < 4; ++it)
#pragma unroll
        for (int j = 0; j < 8; ++j) am = amax4(am, v[it][j]);
    am = wave_max(am);
    __syncthreads();
    if (lane == 0) red[w] = am;
    __syncthreads();
    float gmx = red[0];
#pragma unroll
    for (int i = 1; i < NWAVES; ++i) gmx = fmaxf(gmx, red[i]);
    const float sc = gmx > 0.f ? 127.f / gmx : 0.f;
    if (F.tid == 0) ((float*)(F.ws + WS_WSC))[nb] = gmx * (1.f / 127.f);
    int row0;
    if (32 * nb >= GA0) { const int n1 = 32 * nb - GA0, isb = n1 >> 11, mc0 = n1 & (DM - 1); row0 = GA0 + (mc0 >> 7) * 256 + 128 * isb + 32 * ((mc0 >> 5) & 3); }
    else row0 = std_row0(32 * nb);
    unsigned char* dst = F.ws + WS_WIN8 + (size_t)row0 * DM + 256 * w;
    const int c = lane & 7;
#pragma unroll
    for (int it = 0; it < 4; ++it) {
#pragma unroll
        for (int j = 0; j < 8; ++j) { LAS float* d = scr + ((lane >> 3) + 8 * j) * 33 + 4 * c; const f32x4 q = v[it][j] * sc; d[0] = q[0]; d[1] = q[1]; d[2] = q[2]; d[3] = q[3]; }
        LDS_WAIT(); asm volatile("" ::: "memory");
#pragma unroll
        for (int j = 0; j < 4; ++j) { const int n = (lane >> 3) + 8 * j; const LAS float* sp = scr + (8 * c) * 33 + n;
            u32x2 o; o.x = pki8(sp[0 * 33], sp[1 * 33], sp[2 * 33], sp[3 * 33]); o.y = pki8(sp[4 * 33], sp[5 * 33], sp[6 * 33], sp[7 * 33]);
            *(GAS u32x2*)(dst + 64 * it + (size_t)perm_in(n) * DM + 8 * c) = o; }
        LDS_WAIT(); asm volatile("" ::: "memory");
    }
}

__device__ __forceinline__ void p0_prologue(const Frame& F) {
    LAS float* scr = (LAS float*)(F.lds + F.wave * 16384);
    bf16_t* Wup_t = (bf16_t*)(F.ws + WS_WUP); bf16_t* Wout_t = (bf16_t*)(F.ws + WS_WOUT);
    constexpr int NGRP = INC / 32;
    for (int nb = F.vcu; nb < NGRP; nb += F.G) convert_w_in_i8(F, nb);
    const int nheavy = (F.G < NGRP && 2 * (NGRP % F.G) <= F.G) ? NGRP % F.G : 0;
    if (F.vcu >= nheavy) {
    const int gw = (F.vcu - nheavy) * NWAVES + F.wave, NGW = (F.G - nheavy) * NWAVES;
    constexpr int I_UP = (1024 / 64) * (DM / 32);
    constexpr int I_OUT = (DM / 64) * (DM / 32);
    constexpr int NITEMS = 2 * I_UP + I_OUT;
    struct Dec0 { const float *w_upa, *w_upb, *w_out; bf16_t *Wup_t, *Wout_t;
        __device__ __forceinline__ CvItem operator()(int r) const {
            if (r < 2 * I_UP) { const int half = r / I_UP; r -= half * I_UP; const int nblk = DM / 32, kb = r / nblk, nb = r % nblk;
                return CvItem{(half ? w_upb : w_upa) + (size_t)(64 * kb) * DM + 32 * nb, Wup_t + (size_t)half * DM * 1024 + (size_t)std_row0(32 * nb) * 1024 + 64 * kb, DM, 1024, nullptr, 0.f}; } r -= 2 * I_UP;
            const int nblk = DM / 32, kb = r / nblk, nb = r % nblk; return CvItem{w_out + (size_t)(64 * kb) * DM + 32 * nb, Wout_t + (size_t)std_row0(32 * nb) * DM + 64 * kb, DM, DM, nullptr, 0.f}; } };
    convert_list(Dec0{F.w_upa, F.w_upb, F.w_out, Wup_t, Wout_t}, gw, NGW, NITEMS, scr, F.lane);
    f32x4 gm[8];
#pragma unroll
    for (int j = 0; j < 8; ++j) gm[j] = ((const GAS f32x4*)F.g_mix)[F.lane + 64 * j];
    for (int m = gw; m < NTOK; m += NGW) {
        const GAS f32x4* xr = (const GAS f32x4*)(F.x + (size_t)m * DM) + F.lane;
        f32x4 v[8]; float s = 0.f;
#pragma unroll
        for (int j = 0; j < 8; ++j) { v[j] = xr[64 * j]; s += (v[j].x * v[j].x + v[j].y * v[j].y) + (v[j].z * v[j].z + v[j].w * v[j].w); }
        const float rstd = 1.0f / sqrtf(wave_sum(s) * (1.f / DM) + EPS);
        float am = 0.f;
#pragma unroll
        for (int j = 0; j < 8; ++j) { v[j] = v[j] * rstd * gm[j]; am = amax4(am, v[j]); }
        am = wave_max(am);
        const float sc = am > 0.f ? 127.f / am : 0.f;
        if (F.lane == 0) ((float*)(F.ws + WS_XS))[m] = am * (1.f / 127.f);
#pragma unroll
        for (int j = 0; j < 8; ++j) { const f32x4 y = v[j] * sc; ((GAS unsigned*)(F.ws + WS_X8 + (size_t)m * DM))[F.lane + 64 * j] = pki8(y.x, y.y, y.z, y.w); }
    }
    }
    { bf16_t* GWT = (bf16_t*)(F.ws + WS_GWT);
      for (int idx = F.vcu * 512 + F.tid; idx < 32 * DM; idx += F.G * 512) { const int j = idx >> 11, d = idx & (DM - 1); float v = 0.f;
          if (j < 4) v = F.w_rg[d * 4 + j]; else if (j < 20) v = F.w_re[((size_t)((j - 4) >> 2) * DM + d) * 4 + ((j - 4) & 3)];
          GWT[idx] = (bf16_t)f2bf(v * F.g_ffn[d]); } }
    { GAS u32x4* z = (GAS u32x4*)(F.ws + WS_SL); for (int i = F.vcu * 512 + F.tid; i < (int)(2 * MiB / 16); i += F.G * 512) z[i] = (u32x4){0u, 0u, 0u, 0u}; }
    { GAS u32x4* z = (GAS u32x4*)(F.ws + WS_BK); for (int i = F.vcu * 512 + F.tid; i < (int)(BK_BYTES / 16); i += F.G * 512) z[i] = (u32x4){0u, 0u, 0u, 0u}; }
    float* KS = (float*)(F.ws + WS_KSUM);
    for (int i = F.vcu * 512 + F.tid; i < NB * 16 * 8 * 64; i += F.G * 512) KS[i] = 0.f;
}

struct CvBlock { const float* src; unsigned char* dst; const float* gk; int kind, e, isup, nblk; };
template <class Dec> __device__ __forceinline__ void convert_blocks_fp8(const Frame& F, const Dec& dec, int wg, int nwg, int nblocks, int ldw, int ldt, float sc) {
    if (wg >= nblocks) return;
    LAS unsigned char* T = F.lds;
    const int lane = F.lane, w = F.wave;
    f32x4 v[16]; float gl;
    CvBlock cur = dec(wg);
#define CVB_LOAD(blk) do { const float* _s = (blk).src + (size_t)(16 * w) * ldw + 4 * lane; _Pragma("unroll") for (int j = 0; j < 16; ++j) v[j] = *(const GAS f32x4*)(_s + (size_t)j * ldw); \
        gl = (blk).gk ? (blk).gk[16 * w + (lane & 15)] * sc : sc; } while (0)
    CVB_LOAD(cur);
    for (int it = wg; it < nblocks; it += nwg) {
        const int sw = 16 * (lane & 7);
#pragma unroll
        for (int q = 0; q < 4; ++q) {
            const float g0 = __builtin_bit_cast(float, __builtin_amdgcn_readlane(__builtin_bit_cast(int, gl), 4 * q)), g1 = __builtin_bit_cast(float, __builtin_amdgcn_readlane(__builtin_bit_cast(int, gl), 4 * q + 1)),
                        g2 = __builtin_bit_cast(float, __builtin_amdgcn_readlane(__builtin_bit_cast(int, gl), 4 * q + 2)), g3 = __builtin_bit_cast(float, __builtin_amdgcn_readlane(__builtin_bit_cast(int, gl), 4 * q + 3));
#pragma unroll
            for (int i = 0; i < 4; ++i) *(LAS unsigned*)(T + (4 * lane + i) * 128 + ((16 * w + 4 * q) ^ sw)) = pk8(v[4 * q][i] * g0, v[4 * q + 1][i] * g1, v[4 * q + 2][i] * g2, v[4 * q + 3][i] * g3);
        }
        const int nx = it + nwg; CvBlock nxt = cur; if (nx < nblocks) { nxt = dec(nx); CVB_LOAD(nxt); }
        LDS_WAIT(); asm volatile("" ::: "memory"); __builtin_amdgcn_s_barrier(); asm volatile("" ::: "memory");
#pragma unroll
        for (int r = 0; r < 4; ++r) { const int n = 32 * w + 8 * r + (lane >> 3), c = lane & 7;
            const u32x4 d = *(const LAS u32x4*)(T + n * 128 + ((16 * c) ^ (16 * ((n >> 2) & 7))));
            int row; if (cur.kind == 0) { const int hc = 256 * cur.nblk + n; row = (hc >> 7) * 256 + 128 * cur.isup + 32 * ((hc >> 5) & 3) + perm_in(hc & 31); } else { const int col = 256 * cur.nblk + n; row = std_row0(col & ~31) + perm_in(col & 31); }
            *(GAS u32x4*)(cur.dst + (size_t)row * ldt + 16 * c) = d; }
        LDS_WAIT(); asm volatile("" ::: "memory"); __builtin_amdgcn_s_barrier(); asm volatile("" ::: "memory");
        cur = nxt;
    }
#undef CVB_LOAD
}
__device__ __forceinline__ void convert_moe_gate_up(const Frame& F, int wg, int nwg) {
    struct Dec { const float *w_ge, *w_ue, *g_ffn; unsigned char* Wgu;
        __device__ __forceinline__ CvBlock operator()(int r) const { const int nblk = r & 1, kb = (r >> 1) & 15, e = (r >> 5) & 15, isup = r >> 9;
            return CvBlock{(isup ? w_ue : w_ge) + (size_t)e * DM * DEXP + (size_t)(128 * kb) * DEXP + 256 * nblk, Wgu + (size_t)e * 1024 * DM + 128 * kb, g_ffn + 128 * kb, 0, e, isup, nblk}; } };
    convert_blocks_fp8(F, Dec{F.w_ge, F.w_ue, F.g_ffn, F.ws + WS_WGU}, wg, nwg, 2 * NEXP * 16 * 2, DEXP, DM, SW8);
}
__device__ __forceinline__ void convert_moe_down(const Frame& F, int wg, int nwg) {
    struct Dec { const float* w_de; unsigned char* Wd;
        __device__ __forceinline__ CvBlock operator()(int r) const { const int nblk = r & 7, kb = (r >> 3) & 3, e = r >> 5;
            return CvBlock{w_de + (size_t)e * DEXP * DM + (size_t)(128 * kb) * DM + 256 * nblk, Wd + (size_t)e * DM * DEXP + 128 * kb, nullptr, 1, e, 0, nblk}; } };
    convert_blocks_fp8(F, Dec{F.w_de, F.ws + WS_WD}, wg, nwg, NEXP * 4 * 8, DM, DEXP, SD8);
}

struct SchedTiles {
    const char* A; const char* Bt; int nM, nN, K, G, c;
    __device__ __forceinline__ bool next(int i, g8::Unit& u) const {
        int pm, pn; if (!g8::tile_order(nM, nN, G, c, i, pm, pn)) return false;
        u.a = A + (size_t)pm * 256 * K * 2; u.b = Bt + (size_t)pn * 256 * K * 2; u.rows = nullptr; u.nkt = K / 64; u.pm = pm; u.pn = pn; u.x0 = 0; u.x1 = 0; return true;
    }
};
struct SchedIn8 {
    const char* A; const char* Bt; int G, c;
    __device__ __forceinline__ bool next(int i, g8::Unit& u) const {
        int pm, pn; if (!g8::tile_order(NTOK / 256, INC / 256, G, c, i, pm, pn)) return false;
        u.a = A + (size_t)pm * 256 * DM; u.b = Bt + (size_t)pn * 256 * DM; u.rows = nullptr; u.nkt = DM / 128; u.pm = pm; u.pn = pn; u.x0 = 0; u.x1 = 0; return true;
    }
};
struct EpiGate8 {
    bf16_t* P; const float* XS; const float* WSC;
    __device__ __forceinline__ bool operator()(f32x4 (&acc)[2][2][4][2], const g8::Unit& u, int wr, int wc, int fr, int fq) const {
        const int t = u.pn - NT_QKV, mcol = t * 128 + wc * 32 + 8 * fq;
        const float wa = ld_agent_f(WSC + GA0 / 32 + 4 * t + wc) * -LOG2E, wb = ld_agent_f(WSC + GB0 / 32 + 4 * t + wc) * -LOG2E;
#pragma unroll
        for (int ai = 0; ai < 2; ++ai)
#pragma unroll
            for (int m = 0; m < 4; ++m) { const int row = u.pm * 256 + ai * 128 + wr * 64 + m * 16 + fr;
                const float xr = ld_agent_f(XS + row), sa_ = xr * wa, sb_ = xr * wb;
                float rr[8], sbv[8];
#pragma unroll
                for (int n = 0; n < 2; ++n) { const i32x4 ia = __builtin_bit_cast(i32x4, acc[ai][0][m][n]), ib = __builtin_bit_cast(i32x4, acc[ai][1][m][n]);
#pragma unroll
                    for (int i = 0; i < 4; ++i) { const float ea = 1.0f + __builtin_amdgcn_exp2f((float)ia[i] * sa_), eb = 1.0f + __builtin_amdgcn_exp2f((float)ib[i] * sb_);
                        rr[4 * n + i] = eb * __builtin_amdgcn_rcpf(ea); sbv[4 * n + i] = __builtin_amdgcn_rcpf(eb); } }
                u32x4 wr_, ws_; wr_.x = pk2(rr[0], rr[1]); wr_.y = pk2(rr[2], rr[3]); wr_.z = pk2(rr[4], rr[5]); wr_.w = pk2(rr[6], rr[7]);
                ws_.x = pk2(sbv[0], sbv[1]); ws_.y = pk2(sbv[2], sbv[3]); ws_.z = pk2(sbv[4], sbv[5]); ws_.w = pk2(sbv[6], sbv[7]);
                *(GAS u32x4*)(P + (size_t)row * INC + GA0 + mcol) = wr_; *(GAS u32x4*)(P + (size_t)row * INC + GB0 + mcol) = ws_; }
        return false;
    }
};
struct EpiProj {
    bf16_t* P; float* KS; const float *qn_a, *kn_a, *qn_b, *kn_b; const float* XS; const float* WSC;
    __device__ __forceinline__ bool operator()(f32x4 (&acc)[2][2][4][2], const g8::Unit& u, int wr, int wc, int fr, int fq) const {
        const int pn = u.pn;
        int kind; const float* gain = nullptr;
        if (pn < 4) { kind = 2; gain = qn_a; } else if (pn == 4) { if (wc < 2) { kind = 1; gain = kn_a; } else kind = 0; }
        else if (pn < 9) { kind = 2; gain = qn_b; } else if (pn < 13) { kind = 3; gain = kn_b; } else kind = 0;
        const int colbase = pn * 256 + wc * 64 + 8 * fq;
        { const float w0 = ld_agent_f(WSC + pn * 8 + wc * 2), w1 = ld_agent_f(WSC + pn * 8 + wc * 2 + 1);
#pragma unroll
          for (int ai = 0; ai < 2; ++ai)
#pragma unroll
              for (int m = 0; m < 4; ++m) { const float xr = ld_agent_f(XS + u.pm * 256 + ai * 128 + wr * 64 + m * 16 + fr);
#pragma unroll
                  for (int bj = 0; bj < 2; ++bj) { const float sc = xr * (bj ? w1 : w0);
#pragma unroll
                      for (int n = 0; n < 2; ++n) { const i32x4 iv = __builtin_bit_cast(i32x4, acc[ai][bj][m][n]); acc[ai][bj][m][n] = (f32x4){(float)iv[0] * sc, (float)iv[1] * sc, (float)iv[2] * sc, (float)iv[3] * sc}; } } } }
        f32x4 gv[2][2];
        if (kind != 0) {
#pragma unroll
            for (int bj = 0; bj < 2; ++bj)
#pragma unroll
                for (int n = 0; n < 2; ++n) gv[bj][n] = *(const GAS f32x4*)(gain + 32 * bj + 8 * fq + 4 * n);
            if (kind == 2) {
#pragma unroll
                for (int bj = 0; bj < 2; ++bj)
#pragma unroll
                    for (int n = 0; n < 2; ++n) gv[bj][n] = gv[bj][n] * QSCALE;
            }
        }
        f32x4 ks[2][2];
#pragma unroll
        for (int bj = 0; bj < 2; ++bj)
#pragma unroll
            for (int n = 0; n < 2; ++n) ks[bj][n] = (f32x4){0.f, 0.f, 0.f, 0.f};
#pragma unroll
        for (int ai = 0; ai < 2; ++ai)
#pragma unroll
            for (int m = 0; m < 4; ++m) { const int row = u.pm * 256 + ai * 128 + wr * 64 + m * 16 + fr;
                if (kind != 0) {
                    float s = 0.f;
#pragma unroll
                    for (int bj = 0; bj < 2; ++bj)
#pragma unroll
                        for (int n = 0; n < 2; ++n) { const f32x4 v = acc[ai][bj][m][n]; s += (v[0] * v[0] + v[1] * v[1]) + (v[2] * v[2] + v[3] * v[3]); }
                    s += __shfl_xor(s, 16); s += __shfl_xor(s, 32);
                    const float rstd = 1.0f / sqrtf(s * (1.f / 64.f) + EPS);
#pragma unroll
                    for (int bj = 0; bj < 2; ++bj)
#pragma unroll
                        for (int n = 0; n < 2; ++n) { acc[ai][bj][m][n] = acc[ai][bj][m][n] * rstd * gv[bj][n]; if (kind == 3) ks[bj][n] += acc[ai][bj][m][n]; }
                }
#pragma unroll
                for (int bj = 0; bj < 2; ++bj) { u32x4 w; const f32x4 a = acc[ai][bj][m][0], b = acc[ai][bj][m][1];
                    w.x = pk2(a[0], a[1]); w.y = pk2(a[2], a[3]); w.z = pk2(b[0], b[1]); w.w = pk2(b[2], b[3]);
                    *(GAS u32x4*)(P + (size_t)row * INC + colbase + 32 * bj) = w; } }
        if (kind == 3) {
            const int bb = u.pm >> 3, blk = u.pm & 7, h = (pn - 9) * 4 + wc;
            float* dst = KS + ((size_t)((bb * 16 + h) * 8 + blk)) * 64 + 8 * fq;
#pragma unroll
            for (int bj = 0; bj < 2; ++bj)
#pragma unroll
                for (int n = 0; n < 2; ++n)
#pragma unroll
                    for (int i = 0; i < 4; ++i) { float v = ks[bj][n][i]; v += __shfl_xor(v, 1); v += __shfl_xor(v, 2); v += __shfl_xor(v, 4); v += __shfl_xor(v, 8);
                        if (fr == 0) atomicAdd(dst + 32 * bj + 4 * n + i, v); }
        }
        return false;
    }
};

struct EpiIn8 { EpiProj p; EpiGate8 g;
    __device__ __forceinline__ bool operator()(f32x4 (&acc)[2][2][4][2], const g8::Unit& u, int wr, int wc, int fr, int fq) const { return (u.pn >= NT_QKV) ? g(acc, u, wr, wc, fr, fq) : p(acc, u, wr, wc, fr, fq); }
};

__device__ __forceinline__ void load_q64(float (&q)[64], const bf16_t* p) {
#pragma unroll
    for (int c = 0; c < 8; ++c) { const u32x4 w = *(const GAS u32x4*)(p + 8 * c);
        q[8 * c + 0] = bf_lo(w.x); q[8 * c + 1] = bf_hi(w.x); q[8 * c + 2] = bf_lo(w.y); q[8 * c + 3] = bf_hi(w.y);
        q[8 * c + 4] = bf_lo(w.z); q[8 * c + 5] = bf_hi(w.z); q[8 * c + 6] = bf_lo(w.w); q[8 * c + 7] = bf_hi(w.w); }
}
__device__ __forceinline__ float dot_q64(const float (&q)[64], const bf16_t* p) {
    float s0 = 0.f, s1 = 0.f;
#pragma unroll
    for (int c = 0; c < 8; ++c) { const u32x4 w = *(const GAS u32x4*)(p + 8 * c);
        s0 += q[8 * c + 0] * bf_lo(w.x); s1 += q[8 * c + 1] * bf_hi(w.x); s0 += q[8 * c + 2] * bf_lo(w.y); s1 += q[8 * c + 3] * bf_hi(w.y);
        s0 += q[8 * c + 4] * bf_lo(w.z); s1 += q[8 * c + 5] * bf_hi(w.z); s0 += q[8 * c + 6] * bf_lo(w.w); s1 += q[8 * c + 7] * bf_hi(w.w); }
    return s0 + s1;
}
__device__ __forceinline__ void attn_naive(const Frame& F) {
    const bf16_t* P = (const bf16_t*)(F.ws + WS_PROJ); const float* KS = (const float*)(F.ws + WS_KSUM);
    bf16_t* OA = (bf16_t*)(F.ws + WS_XN); bf16_t* OB = OA + (size_t)NTOK * 1024;
    LAS float* pbuf = (LAS float*)(F.lds + F.wave * 4096);
    const int gw = F.vcu * NWAVES + F.wave, NGW = F.G * NWAVES, lane = F.lane;
    const int NTASK = 2 * NB * 16 * SEQ;
    for (int k = 0; k * NGW < NTASK; ++k) {
        const int base = k * NGW; const int idx = base + ((gw + 37 * k) % NGW);
        if (idx >= NTASK) continue;
        const int which = idx / (NB * 16 * SEQ); const int r = idx % (NB * 16 * SEQ);
        const int b = r / (16 * SEQ), h = (r / SEQ) % 16, s = r % SEQ;
        const size_t row = (size_t)b * SEQ + s;
        const float slope = __builtin_amdgcn_exp2f(-0.5f * (float)(h + 1)) * LOG2E;
        float q[64];
        if (which == 0) {
            const int kv = h >> 3;
            load_q64(q, P + row * INC + QA0 + h * 64);
            float lsum = 0.f;
#pragma unroll
            for (int c = 0; c < 2; ++c) { const int kpos = s - 127 + lane + 64 * c; float p = 0.f;
                if (kpos >= 0) { const float sc = dot_q64(q, P + ((size_t)b * SEQ + kpos) * INC + KA0 + kv * 64) - slope * (float)(s - kpos); p = __builtin_amdgcn_exp2f(sc); }
                pbuf[64 * c + lane] = p; lsum += p; }
            lsum = wave_sum(lsum) + __builtin_amdgcn_exp2f(F.sinks[h] * LOG2E);
            LDS_WAIT(); asm volatile("" ::: "memory");
            float o = 0.f;
            for (int j = 0; j < 128; ++j) { const int kpos = s - 127 + j; if (kpos < 0) continue;
                const float v = bf_lo((unsigned)P[((size_t)b * SEQ + kpos) * INC + VA0 + kv * 64 + lane]); o += pbuf[j] * v; }
            OA[row * 1024 + h * 64 + lane] = (bf16_t)f2bf(o / lsum);
            LDS_WAIT(); asm volatile("" ::: "memory");
        } else {
            const int t = s >> 8;
            load_q64(q, P + row * INC + QB0 + h * 64);
            float g = -INFINITY;
            if (lane < t) { const float* kr = KS + ((size_t)((b * 16 + h) * 8 + lane)) * 64; float a = 0.f;
#pragma unroll
                for (int d = 0; d < 64; ++d) a += q[d] * ld_agent_f(kr + d);
                g = a; }
            unsigned selmask;
            if (t <= 3) selmask = (1u << t) - 1u;
            else { int rank = 0;
#pragma unroll
                for (int i = 0; i < 7; ++i) { const float gi = __shfl(g, i); if (i < t && (gi > g || (gi == g && i < lane))) ++rank; }
                selmask = (unsigned)__ballot(lane < t && rank < 3); }
            float lsum = 0.f; int nslot = 0; int blk_of[4] = {0, 0, 0, 0};
            for (int j = 0; j <= t; ++j) {
                if (j < t && !((selmask >> j) & 1u)) continue;
#pragma unroll
                for (int c = 0; c < 4; ++c) { const int kpos = 256 * j + 64 * c + lane; float p = 0.f;
                    if (kpos <= s) { const float sc = dot_q64(q, P + ((size_t)b * SEQ + kpos) * INC + KB0 + h * 64) - slope * (float)(s - kpos); p = __builtin_amdgcn_exp2f(sc); }
                    pbuf[nslot * 256 + 64 * c + lane] = p; lsum += p; }
                if (nslot == 0) blk_of[0] = j; else if (nslot == 1) blk_of[1] = j; else if (nslot == 2) blk_of[2] = j; else blk_of[3] = j;
                ++nslot;
            }
            lsum = wave_sum(lsum);
            LDS_WAIT(); asm volatile("" ::: "memory");
            float o = 0.f;
            for (int sl = 0; sl < nslot; ++sl) { const int j = sl == 0 ? blk_of[0] : sl == 1 ? blk_of[1] : sl == 2 ? blk_of[2] : blk_of[3];
                for (int kk = 0; kk < 256; ++kk) { const int kpos = 256 * j + kk; if (kpos > s) break;
                    const float v = bf_lo((unsigned)P[((size_t)b * SEQ + kpos) * INC + VB0 + h * 64 + lane]); o += pbuf[sl * 256 + kk] * v; } }
            OB[row * 1024 + h * 64 + lane] = (bf16_t)f2bf(o / lsum);
            LDS_WAIT(); asm volatile("" ::: "memory");
        }
    }
}

namespace att {
typedef float f32x16 __attribute__((ext_vector_type(16)));
typedef short s16x4 __attribute__((ext_vector_type(4)));
typedef __bf16 bf16x2_t __attribute__((ext_vector_type(2)));
__device__ __forceinline__ unsigned cvtpk(float lo, float hi) { f32x2 v = {lo, hi}; bf16x2_t b = __builtin_convertvector(v, bf16x2_t); return __builtin_bit_cast(unsigned, b); }
__device__ __forceinline__ s16x4 vtr(const LAS char* p) { return __builtin_bit_cast(s16x4, __builtin_amdgcn_ds_read_tr16_b64_v4i16((LAS s16x4*)p)); }
__device__ __forceinline__ void tile_map(int wave, int lane, int& key, int& chunk) { chunk = lane & 7; key = 8 * wave + (((lane >> 3) + (lane & 7)) & 7); }
__device__ __forceinline__ int k_off(int key, int chunk) { return chunk * 1024 + key * 16; }
__device__ __forceinline__ int v_off(int key, int chunk) { return ((chunk >> 2) * 4 + (key >> 4)) * 1024 + (key & 15) * 64 + (chunk & 3) * 16; }

__device__ __forceinline__ void tile_qk(f32x16& p0, f32x16& p1, const LAS char* Kt, const bf16x8 (&qr)[4], float base_l, float ch, int lane) {
    const int r32 = lane & 31, hi = lane >> 5;
#pragma unroll
    for (int r = 0; r < 16; ++r) { p0[r] = base_l + ch * (float)((r & 3) + 8 * (r >> 2)); p1[r] = p0[r] + 32.f * ch; }
    const LAS char* kp = Kt + hi * 1024 + r32 * 16;
    bf16x8 kf[8];
#pragma unroll
    for (int d0 = 0; d0 < 4; ++d0) { kf[2 * d0] = *(const LAS bf16x8*)(kp + d0 * 2048); kf[2 * d0 + 1] = *(const LAS bf16x8*)(kp + d0 * 2048 + 512); }
    __builtin_amdgcn_s_setprio(1);
#pragma unroll
    for (int d0 = 0; d0 < 4; ++d0) {
        p0 = __builtin_amdgcn_mfma_f32_32x32x16_bf16(kf[2 * d0], qr[d0], p0, 0, 0, 0);
        p1 = __builtin_amdgcn_mfma_f32_32x32x16_bf16(kf[2 * d0 + 1], qr[d0], p1, 0, 0, 0);
    }
    __builtin_amdgcn_s_setprio(0);
}
template <int MODE>
__device__ __forceinline__ void tile_sm(f32x16& p0, f32x16& p1, u32x4 (&pw)[4], float& lsum, int qrel, int lane) {
    const int hi = lane >> 5;
    if (MODE != 0) {
#pragma unroll
        for (int r = 0; r < 16; ++r) { const int kk = (r & 3) + 8 * (r >> 2) + 4 * hi; const int d0_ = qrel - kk, d1_ = d0_ - 32;
            const bool ok0 = MODE == 1 ? (d0_ >= 0) : (d0_ >= 0 && d0_ < 128), ok1 = MODE == 1 ? (d1_ >= 0) : (d1_ >= 0 && d1_ < 128);
            p0[r] = ok0 ? p0[r] : -INFINITY; p1[r] = ok1 ? p1[r] : -INFINITY; }
    }
    float s = 0.f;
#pragma unroll
    for (int r = 0; r < 16; ++r) { p0[r] = __builtin_amdgcn_exp2f(p0[r]); p1[r] = __builtin_amdgcn_exp2f(p1[r]); s += p0[r] + p1[r]; }
    lsum += s;
#pragma unroll
    for (int i = 0; i < 4; ++i) { pw[0][i] = cvtpk(p0[2 * i], p0[2 * i + 1]); pw[1][i] = cvtpk(p0[8 + 2 * i], p0[8 + 2 * i + 1]); pw[2][i] = cvtpk(p1[2 * i], p1[2 * i + 1]); pw[3][i] = cvtpk(p1[8 + 2 * i], p1[8 + 2 * i + 1]); }
}
__device__ __forceinline__ void tile_pv(f32x16 (&ot)[2], const LAS char* Vt, const u32x4 (&pw)[4], int lane) {
    const int hi = lane >> 5;
    const LAS char* vp = Vt + ((lane >> 4) & 1) * 32 + (lane & 3) * 8 + (4 * hi + ((lane & 15) >> 2)) * 64;
#pragma unroll
    for (int dh = 0; dh < 2; ++dh) {
        bf16x8 vf[4];
#pragma unroll
        for (int ks = 0; ks < 4; ++ks) { const s16x4 lo = vtr(vp + dh * 4096 + ks * 1024), hh = vtr(vp + dh * 4096 + ks * 1024 + 512);
            vf[ks] = (bf16x8){lo[0], lo[1], lo[2], lo[3], hh[0], hh[1], hh[2], hh[3]}; }
        __builtin_amdgcn_s_setprio(1);
#pragma unroll
        for (int ks = 0; ks < 4; ++ks) ot[dh] = __builtin_amdgcn_mfma_f32_32x32x16_bf16(vf[ks], __builtin_bit_cast(bf16x8, pw[ks]), ot[dh], 0, 0, 0);
        __builtin_amdgcn_s_setprio(0);
    }
}
template <int MODE>
__device__ __forceinline__ void tile_step(const LAS char* Kt, const LAS char* Vt, const bf16x8 (&qr)[4], f32x16 (&ot)[2], float& lsum, float base_l, float ch, int qrel, int lane) {
    f32x16 p0, p1; u32x4 pw[4];
    tile_qk(p0, p1, Kt, qr, base_l, ch, lane);
    tile_sm<MODE>(p0, p1, pw, lsum, qrel, lane);
    tile_pv(ot, Vt, pw, lane);
}
__device__ __forceinline__ void store_o(bf16_t* orow, const f32x16 (&ot)[2], float inv, int hi) {
#pragma unroll
    for (int dh = 0; dh < 2; ++dh)
#pragma unroll
        for (int g = 0; g < 4; ++g) { u32x2 w; w.x = pk2(ot[dh][4 * g] * inv, ot[dh][4 * g + 1] * inv); w.y = pk2(ot[dh][4 * g + 2] * inv, ot[dh][4 * g + 3] * inv);
            *(GAS u32x2*)(orow + 32 * dh + 8 * g + 4 * hi) = w; }
}
__device__ __forceinline__ void load_q(bf16x8 (&qr)[4], const bf16_t* qrow, int hi) {
#pragma unroll
    for (int d0 = 0; d0 < 4; ++d0) qr[d0] = *(const GAS bf16x8*)(qrow + 16 * d0 + 8 * hi);
}

__device__ __forceinline__ void swa_unit(const Frame& F, LAS char* L, int b, int n, int kv, int gh) {
    const bf16_t* P = (const bf16_t*)(F.ws + WS_PROJ); bf16_t* OA = (bf16_t*)(F.ws + WS_XN);
    const int lane = F.lane, w = F.wave, r32 = lane & 31, hi = lane >> 5;
    int key, chunk; tile_map(w, lane, key, chunk);
    const int wb = 128 * n - 128;
    u32x4 kr[4], vr[4];
#pragma unroll
    for (int i = 0; i < 4; ++i) if (n > 0 || i >= 2) { const bf16_t* src = P + ((size_t)b * SEQ + wb + 64 * i + key) * INC + kv * 64 + chunk * 8;
        kr[i] = *(const GAS u32x4*)(src + KA0); vr[i] = *(const GAS u32x4*)(src + VA0); }
#pragma unroll
    for (int i = 0; i < 4; ++i) if (n > 0 || i >= 2) { *(LAS u32x4*)(L + i * 8192 + k_off(key, chunk)) = kr[i]; *(LAS u32x4*)(L + 32768 + i * 8192 + v_off(key, chunk)) = vr[i]; }
    LDS_WAIT(); __syncthreads();
    const int hq = kv * 8 + gh * 4 + (w >> 1);
    const float ch = __builtin_amdgcn_exp2f(-0.5f * (float)(hq + 1)) * LOG2E;
    const float sink = __builtin_amdgcn_exp2f(F.sinks[hq] * LOG2E);
#pragma unroll 1
    for (int sub = 0; sub < 2; ++sub) {
        const int q0w = 64 * (w & 1) + 32 * sub, qw = 128 + q0w + r32;
        const size_t row = (size_t)b * SEQ + 128 * n + q0w + r32;
        bf16x8 qr[4]; load_q(qr, P + row * INC + QA0 + hq * 64, hi);
        f32x16 ot[2]; float lsum = 0.f;
#pragma unroll
        for (int r = 0; r < 16; ++r) { ot[0][r] = 0.f; ot[1][r] = 0.f; }
        const int i0 = q0w >> 6;
#pragma unroll 1
        for (int i = i0; i < i0 + 3; ++i) { if (n == 0 && i < 2) continue;
            tile_step<2>(L + i * 8192, L + 32768 + i * 8192, qr, ot, lsum, ch * (float)(64 * i - qw + 4 * hi), ch, qw - 64 * i, lane); }
        lsum += __shfl_xor(lsum, 32); lsum += sink;
        store_o(OA + row * 1024 + hq * 64, ot, 1.0f / lsum, hi);
    }
    __syncthreads();
}
__device__ __forceinline__ void moba_unit(const Frame& F, LAS char* L, int b, int h, int t) {
    const bf16_t* P = (const bf16_t*)(F.ws + WS_PROJ); const float* KS = (const float*)(F.ws + WS_KSUM); bf16_t* OB = (bf16_t*)(F.ws + WS_XN) + (size_t)NTOK * 1024;
    const int lane = F.lane, w = F.wave, r32 = lane & 31, hi = lane >> 5;
    int key, chunk; tile_map(w, lane, key, chunk);
    const int qpos = 256 * t + 32 * w + r32;
    const size_t row = (size_t)b * SEQ + qpos;
    bf16x8 qr[4]; load_q(qr, P + row * INC + QB0 + h * 64, hi);
    const float ch = __builtin_amdgcn_exp2f(-0.5f * (float)(h + 1)) * LOG2E;
    unsigned selmask = (1u << t) - 1u;
    if (t > 3) {
        float g[7];
#pragma unroll
        for (int j = 0; j < 7; ++j) { float a = 0.f;
            if (j < t) { const float* kr = KS + ((size_t)((b * 16 + h) * 8 + j)) * 64 + 8 * hi;
#pragma unroll
                for (int d0 = 0; d0 < 4; ++d0) { const f32x4 k0 = *(const GAS f32x4*)(kr + 16 * d0), k1 = *(const GAS f32x4*)(kr + 16 * d0 + 4); const u32x4 qw = __builtin_bit_cast(u32x4, qr[d0]);
                    a += bf_lo(qw.x) * k0[0] + bf_hi(qw.x) * k0[1] + bf_lo(qw.y) * k0[2] + bf_hi(qw.y) * k0[3] + bf_lo(qw.z) * k1[0] + bf_hi(qw.z) * k1[1] + bf_lo(qw.w) * k1[2] + bf_hi(qw.w) * k1[3]; }
                a += __shfl_xor(a, 32); }
            g[j] = (j < t) ? a : -INFINITY; }
        selmask = 0u;
#pragma unroll
        for (int j = 0; j < 7; ++j) { int rank = 0;
#pragma unroll
            for (int i = 0; i < 7; ++i) if (i != j) rank += (g[i] > g[j] || (g[i] == g[j] && i < j)) ? 1 : 0;
            if (j < t && rank < 3) selmask |= 1u << j; }
    }
    f32x16 ot[2]; float lsum = 0.f;
#pragma unroll
    for (int r = 0; r < 16; ++r) { ot[0][r] = 0.f; ot[1][r] = 0.f; }
    const int NS = 2 * (t + 1);
    const bf16_t* src0 = P + ((size_t)b * SEQ + key) * INC + h * 64 + chunk * 8;
    const int ko = k_off(key, chunk), vo = v_off(key, chunk);
#define MOBA_LOAD(R, step) do { const bf16_t* _s = src0 + (size_t)(128 * (step)) * INC; R[0] = *(const GAS u32x4*)(_s + KB0); R[1] = *(const GAS u32x4*)(_s + (size_t)64 * INC + KB0); \
        R[2] = *(const GAS u32x4*)(_s + VB0); R[3] = *(const GAS u32x4*)(_s + (size_t)64 * INC + VB0); } while (0)
#define MOBA_STEP(R, it) do { LAS char* B0 = L + ((it) & 1) * 32768; \
        *(LAS u32x4*)(B0 + ko) = R[0]; *(LAS u32x4*)(B0 + 8192 + ko) = R[1]; *(LAS u32x4*)(B0 + 16384 + vo) = R[2]; *(LAS u32x4*)(B0 + 24576 + vo) = R[3]; \
        LDS_WAIT(); asm volatile("" ::: "memory"); __builtin_amdgcn_s_barrier(); asm volatile("" ::: "memory");     \
        if ((it) + 2 < NS) MOBA_LOAD(R, (it) + 2); \
        const int j = (it) >> 1, tb = 128 * (it); \
        const bool past = j < t; const bool sel = past ? ((selmask >> j) & 1u) != 0u : true; \
        const int dg = past ? 99 : (w >> 1); \
        _Pragma("unroll 1") for (int c = 0; c < 2; ++c) { \
            const int tc = ((it) & 1) * 2 + c, tbc = tb + 64 * c; \
            const float bl = sel ? ch * (float)(tbc - qpos + 4 * hi) : -1e30f; \
            if (tc < dg) tile_step<0>(B0 + c * 8192, B0 + 16384 + c * 8192, qr, ot, lsum, bl, ch, 0, lane); \
            else if (tc == dg) tile_step<1>(B0 + c * 8192, B0 + 16384 + c * 8192, qr, ot, lsum, bl, ch, qpos - tbc, lane); } } while (0)
    u32x4 Ra[4], Rb[4];
    MOBA_LOAD(Ra, 0); MOBA_LOAD(Rb, 1);
#pragma unroll 1
    for (int it = 0; it < NS; it += 2) { MOBA_STEP(Ra, it); MOBA_STEP(Rb, it + 1); }
#undef MOBA_LOAD
#undef MOBA_STEP
    lsum += __shfl_xor(lsum, 32);
    store_o(OB + row * 1024 + h * 64, ot, 1.0f / lsum, hi);
    __syncthreads();
}
__device__ __forceinline__ void attn_phase(const Frame& F) {
    LAS char* L = (LAS char*)F.lds;
    { const int v = F.vcu; swa_unit(F, L, v >> 6, (v >> 2) & 15, (v >> 1) & 1, v & 1); }
    { const int bh = F.vcu >> 2, pr = F.vcu & 3; moba_unit(F, L, bh >> 4, bh & 15, 7 - pr); moba_unit(F, L, bh >> 4, bh & 15, pr); }
}
}

struct SchedUp {
    const char* A; const char* Bt; int G, c;
    __device__ __forceinline__ bool next(int i, g8::Unit& u) const {
        if (i >= 2) return false; int pm, pn; if (!g8::tile_order(32, 8, G, c, 0, pm, pn)) return false;
        u.a = A + ((size_t)i * NTOK + (size_t)pm * 256) * 1024 * 2; u.b = Bt + ((size_t)i * DM + (size_t)pn * 256) * 1024 * 2; u.rows = nullptr; u.nkt = 16; u.pm = pm; u.pn = pn; u.x0 = i; u.x1 = 0; return true;
    }
};
struct EpiUp {
    const bf16_t* P; bf16_t* MG;
    __device__ __forceinline__ bool operator()(f32x4 (&acc)[2][2][4][2], const g8::Unit& u, int wr, int wc, int fr, int fq) const {
        const int col = u.pn * 256 + wc * 64 + 8 * fq; const int gofs = (u.x0 == 0) ? GA0 : GB0;
#pragma unroll
        for (int ai = 0; ai < 2; ++ai) {
            u32x4 gv[4][2];
#pragma unroll
            for (int m = 0; m < 4; ++m)
#pragma unroll
                for (int bj = 0; bj < 2; ++bj) gv[m][bj] = *(const GAS u32x4*)(P + (size_t)(u.pm * 256 + ai * 128 + wr * 64 + m * 16 + fr) * INC + gofs + col + 32 * bj);
#pragma unroll
            for (int m = 0; m < 4; ++m) { const int row = u.pm * 256 + ai * 128 + wr * 64 + m * 16 + fr;
#pragma unroll
                for (int bj = 0; bj < 2; ++bj) {
                    const u32x4 g = gv[m][bj];
                    const float b0 = bf_lo(g.x), b1 = bf_hi(g.x), b2 = bf_lo(g.y), b3 = bf_hi(g.y), b4 = bf_lo(g.z), b5 = bf_hi(g.z), b6 = bf_lo(g.w), b7 = bf_hi(g.w);
                    f32x4& v0 = acc[ai][bj][m][0]; f32x4& v1 = acc[ai][bj][m][1];
                    if (u.x0 == 0) {
                        v0[0] *= b0; v0[1] *= b1; v0[2] *= b2; v0[3] *= b3; v1[0] *= b4; v1[1] *= b5; v1[2] *= b6; v1[3] *= b7;
                    } else {
                        u32x4 w; w.x = pk2(v0[0] * b0, v0[1] * b1); w.y = pk2(v0[2] * b2, v0[3] * b3); w.z = pk2(v1[0] * b4, v1[1] * b5); w.w = pk2(v1[2] * b6, v1[3] * b7);
                        *(GAS u32x4*)(MG + (size_t)row * DM + col + 32 * bj) = w;
                    } } }
        }
        return u.x0 == 0;
    }
};

struct EpiOut {
    const float* X; bf16_t* X1B; float* SS; unsigned char* X8;
    __device__ __forceinline__ bool operator()(f32x4 (&acc)[2][2][4][2], const g8::Unit& u, int wr, int wc, int fr, int fq) const {
        const int col = u.pn * 256 + wc * 64 + 8 * fq;
#pragma unroll
        for (int ai = 0; ai < 2; ++ai) {
            f32x4 xa[4][2], xb[4][2];
#pragma unroll
            for (int m = 0; m < 4; ++m)
#pragma unroll
                for (int bj = 0; bj < 2; ++bj) { const size_t off = (size_t)(u.pm * 256 + ai * 128 + wr * 64 + m * 16 + fr) * DM + col + 32 * bj; xa[m][bj] = *(const GAS f32x4*)(X + off); xb[m][bj] = *(const GAS f32x4*)(X + off + 4); }
#pragma unroll
            for (int m = 0; m < 4; ++m) { const int row = u.pm * 256 + ai * 128 + wr * 64 + m * 16 + fr; float s = 0.f;
#pragma unroll
                for (int bj = 0; bj < 2; ++bj) { const size_t off = (size_t)row * DM + col + 32 * bj;
                    const f32x4 a = xa[m][bj] + acc[ai][bj][m][0], b = xb[m][bj] + acc[ai][bj][m][1];
                    s += (a[0] * a[0] + a[1] * a[1]) + (a[2] * a[2] + a[3] * a[3]) + (b[0] * b[0] + b[1] * b[1]) + (b[2] * b[2] + b[3] * b[3]);
                    u32x4 w; w.x = pk2(a[0], a[1]); w.y = pk2(a[2], a[3]); w.z = pk2(b[0], b[1]); w.w = pk2(b[2], b[3]);
                    *(GAS u32x4*)(X1B + off) = w;
                    u32x2 w8; w8.x = pk8(a[0] * SX8, a[1] * SX8, a[2] * SX8, a[3] * SX8); w8.y = pk8(b[0] * SX8, b[1] * SX8, b[2] * SX8, b[3] * SX8); *(GAS u32x2*)(X8 + off) = w8; }
                s += __shfl_xor(s, 16); s += __shfl_xor(s, 32);
                if (fq == 0) SS[(size_t)row * 32 + u.pn * 4 + wc] = s; }
        }
        return false;
    }
};

__device__ __forceinline__ void p5a_route(const Frame& F) {
    typedef float f32x16 __attribute__((ext_vector_type(16)));
    const bf16_t* X1B = (const bf16_t*)(F.ws + WS_XN); const float* SS = (const float*)(F.ws + WS_SS); const bf16_t* GWT = (const bf16_t*)(F.ws + WS_GWT);
    unsigned* TOS = (unsigned*)(F.ws + WS_SL + SL_TOS); float* WOS = (float*)(F.ws + WS_SL + SL_WOS); float* RSOS = (float*)(F.ws + WS_SL + SL_RSOS);
    unsigned* ECNT = (unsigned*)(F.ws + WS_CTL) + CW_ECNT; unsigned* BCNT = (unsigned*)(F.ws + WS_CTL) + CW_BCNT;
    unsigned* BTOK = (unsigned*)(F.ws + WS_BK + BK_TOK); unsigned* BRA = (unsigned*)(F.ws + WS_BK + BK_RA); unsigned* BRB = (unsigned*)(F.ws + WS_BK + BK_RB);
    LAS unsigned* le = (LAS unsigned*)(F.lds + LDS_X_OFF);
    LAS float* lw = (LAS float*)(le + 64); LAS float* lr = lw + 64; LAS unsigned* lb = (LAS unsigned*)(lr + 32);
    LAS unsigned* lk = lb + 16; LAS unsigned* lkb = lk + 32; LAS unsigned* lsl = lkb + 32;
    LAS float* PT = (LAS float*)F.lds;
    const int lane = F.lane, w = F.wave, r32 = lane & 31, hi = lane >> 5, tokb = F.vcu * 32;
    f32x16 acc;
#pragma unroll
    for (int r = 0; r < 16; ++r) acc[r] = 0.f;
    const bf16_t* xa = X1B + (size_t)(tokb + r32) * DM + 256 * w + 8 * hi; const bf16_t* gb = GWT + (size_t)r32 * DM + 256 * w + 8 * hi;
#pragma unroll 1
    for (int hb = 0; hb < 2; ++hb) {
        bf16x8 af[8], bfr[8];
#pragma unroll
        for (int i = 0; i < 8; ++i) { af[i] = *(const GAS bf16x8*)(xa + 128 * hb + 16 * i); bfr[i] = *(const GAS bf16x8*)(gb + 128 * hb + 16 * i); }
#pragma unroll
        for (int i = 0; i < 8; ++i) acc = __builtin_amdgcn_mfma_f32_32x32x16_bf16(af[i], bfr[i], acc, 0, 0, 0);
    }
#pragma unroll
    for (int r = 0; r < 16; ++r) PT[(w * 32 + ((r & 3) + 8 * (r >> 2) + 4 * hi)) * 32 + r32] = acc[r];
    LDS_WAIT(); __syncthreads();
    LAS float* LG = PT + 8192;
#pragma unroll
    for (int i = 0; i < 2; ++i) { const int o = F.tid + 512 * i; float v = 0.f;
#pragma unroll
        for (int ww = 0; ww < 8; ++ww) v += PT[ww * 1024 + o];
        LG[o] = v; }
    LDS_WAIT(); __syncthreads();
    if (F.tid < 32) {
        const int lt = F.tid, tok = tokb + lt; float ss = 0.f;
#pragma unroll
        for (int j = 0; j < 8; ++j) { const f32x4 p = ((const GAS f32x4*)(SS + (size_t)tok * 32))[j]; ss += (p.x + p.y) + (p.z + p.w); }
        const float rstd = 1.0f / sqrtf(ss * (1.f / DM) + EPS);
        float lgp[4], el[4];
#pragma unroll
        for (int c = 0; c < 4; ++c) lgp[c] = LG[lt * 32 + c] * rstd;
        int gi = 0; float gm = lgp[0];
#pragma unroll
        for (int c = 1; c < 4; ++c) if (lgp[c] > gm) { gm = lgp[c]; gi = c; }
        float gden = 0.f;
#pragma unroll
        for (int c = 0; c < 4; ++c) gden += __expf(lgp[c] - gm);
        const float g_p = 1.0f / gden;
#pragma unroll
        for (int c = 0; c < 4; ++c) el[c] = LG[lt * 32 + 4 + 4 * gi + c] * rstd;
        int e1 = 0; float m1 = el[0];
#pragma unroll
        for (int c = 1; c < 4; ++c) if (el[c] > m1) { m1 = el[c]; e1 = c; }
        int e2 = -1; float m2 = -INFINITY;
#pragma unroll
        for (int c = 0; c < 4; ++c) if (c != e1 && el[c] > m2) { m2 = el[c]; e2 = c; }
        const float w1 = g_p / (1.0f + __expf(m2 - m1)), w2 = g_p / (1.0f + __expf(m1 - m2));
        le[2 * lt] = (unsigned)(gi * 4 + e1); le[2 * lt + 1] = (unsigned)(gi * 4 + e2); lw[2 * lt] = w1; lw[2 * lt + 1] = w2; lr[lt] = rstd;
        const int ea = e1 < e2 ? e1 : e2, eb = e1 < e2 ? e2 : e1;
        lk[lt] = (unsigned)(gi * 6 + ((ea * (7 - ea)) >> 1) + (eb - ea - 1)) | (e1 > e2 ? 64u : 0u);
    }
    LDS_WAIT(); __syncthreads();
    if (F.tid < NEXP) { unsigned c = 0; for (int i = 0; i < 64; ++i) c += (le[i] == (unsigned)F.tid) ? 1u : 0u; lb[F.tid] = c ? __hip_atomic_fetch_add(ECNT + F.tid, c, RLX_AGENT) : 0u; }
    else if (F.tid >= 64 && F.tid < 64 + NBK) { const unsigned b = (unsigned)(F.tid - 64); unsigned c = 0; for (int i = 0; i < 32; ++i) c += ((lk[i] & 63u) == b) ? 1u : 0u; lkb[b] = c ? __hip_atomic_fetch_add(BCNT + b, c, RLX_AGENT) : 0u; }
    LDS_WAIT(); __syncthreads();
    if (F.tid < 64) { const int a = F.tid; const unsigned e = le[a]; unsigned rank = 0;
        for (int i = 0; i < a; ++i) rank += (le[i] == e) ? 1u : 0u;
        const unsigned slot = e * ECAP + lb[e] + rank; const int tok = F.vcu * 32 + (a >> 1);
        TOS[slot] = (unsigned)tok; WOS[slot] = lw[a]; RSOS[slot] = lr[a >> 1]; lsl[a] = slot; }
    LDS_WAIT(); __syncthreads();
    if (F.tid < 32) { const int lt = F.tid; const unsigned kk = lk[lt], b = kk & 63u, sw = kk >> 6; unsigned rank = 0;
        for (int i = 0; i < lt; ++i) rank += ((lk[i] & 63u) == b) ? 1u : 0u;
        const unsigned bs = b * BCAP + lkb[b] + rank;
        BTOK[bs] = (unsigned)(tokb + lt); BRA[bs] = lsl[2 * lt + (int)sw]; BRB[bs] = lsl[2 * lt + 1 - (int)sw]; }
    __syncthreads();
}
struct MoeInfo { unsigned mt0[NEXP + 1]; };
__device__ __forceinline__ int moe_expert_of(const LAS unsigned* mt0, int mtile) { int e = 0;
#pragma unroll
    for (int q = 1; q < NEXP; ++q) if ((unsigned)mtile >= mt0[q]) e = q; return e; }
struct SchedMoeUp {
    const char* H2; const char* Wgu; const int* TOS; const LAS unsigned* mt0; int G, c;
    __device__ __forceinline__ bool next(int i, g8::Unit& u) const {
        const int L = i * G + c; const int nun = (int)mt0[NEXP] * 4; if (L >= nun) return false;
        const int mtile = L >> 2, nt = L & 3, e = moe_expert_of(mt0, mtile), sb = e * ECAP + (mtile - (int)mt0[e]) * 256;
        u.a = H2; u.rows = TOS + sb; u.b = Wgu + ((size_t)e * 1024 + (size_t)nt * 256) * DM; u.nkt = DM / 128; u.pm = mtile; u.pn = nt; u.x0 = e; u.x1 = sb; return true;
    }
};
struct EpiMoeUp {
    const float* WOS; const float* RSOS; bf16_t* HID;
    __device__ __forceinline__ bool operator()(f32x4 (&acc)[2][2][4][2], const g8::Unit& u, int wr, int wc, int fr, int fq) const {
        const int col = u.pn * 128 + wc * 32 + 8 * fq;
        float wv[2][4], rv[2][4];
#pragma unroll
        for (int ai = 0; ai < 2; ++ai)
#pragma unroll
            for (int m = 0; m < 4; ++m) { const int slot = u.x1 + ai * 128 + wr * 64 + m * 16 + fr; wv[ai][m] = WOS[slot]; rv[ai][m] = RSOS[slot] * (1.0f / (SX8 * SW8)); }
#pragma unroll
        for (int ai = 0; ai < 2; ++ai)
#pragma unroll
            for (int m = 0; m < 4; ++m) { const int slot = u.x1 + ai * 128 + wr * 64 + m * 16 + fr; const float w = wv[ai][m], rs = rv[ai][m];
                float hv[8];
#pragma unroll
                for (int n = 0; n < 2; ++n)
#pragma unroll
                    for (int i = 0; i < 4; ++i) { const float g = acc[ai][0][m][n][i] * rs, up = acc[ai][1][m][n][i] * rs;
                        hv[4 * n + i] = g * __builtin_amdgcn_rcpf(1.0f + __builtin_amdgcn_exp2f(-g * LOG2E)) * up * w; }
#pragma unroll
                for (int q = 0; q < 8; ++q) hv[q] = fminf(fmaxf(hv[q] * SH8, -448.f), 448.f);
                u32x2 o; o.x = pk8(hv[0], hv[1], hv[2], hv[3]); o.y = pk8(hv[4], hv[5], hv[6], hv[7]);
                *(GAS u32x2*)((unsigned char*)HID + (size_t)slot * DEXP + col) = o; }
        return false;
    }
};
__device__ __forceinline__ int moe_bucket_of(const LAS unsigned* bt0, int mtile) { int b = 0;
#pragma unroll
    for (int q = 1; q < NBK; ++q) if ((unsigned)mtile >= bt0[q]) b = q; return b; }
struct SchedMoeDown {
    const char* HID; const char* Wd; const int* BRA; const int* BRB; const LAS unsigned* bt0; int G, c;
    __device__ __forceinline__ bool next(int i, g8::Unit& u) const {
        const int h = i & 1, L = (i >> 1) * G + c; const int nun = (int)bt0[NBK] * 8; if (L >= nun) return false;
        const int mtile = L >> 3, pn = L & 7, b = moe_bucket_of(bt0, mtile), lt = mtile - (int)bt0[b], sb = b * BCAP + lt * 256;
        const int g = b / 6, p = b - g * 6, e = g * 4 + (int)(((h ? 0xFB9u : 0x940u) >> (2 * p)) & 3u);
        int lim = (int)bt0[64 + b] - lt * 256; lim = lim > 256 ? 256 : lim;
        u.a = HID; u.rows = (h ? BRB : BRA) + sb; u.b = Wd + ((size_t)e * DM + (size_t)pn * 256) * DEXP; u.nkt = DEXP / 128; u.pm = mtile; u.pn = pn; u.x0 = h | (lim << 1); u.x1 = sb; return true;
    }
};
struct EpiMoeDown {
    float* out; const bf16_t* X1B; const unsigned* BTOK;
    __device__ __forceinline__ bool operator()(f32x4 (&acc)[2][2][4][2], const g8::Unit& u, int wr, int wc, int fr, int fq) const {
        if ((u.x0 & 1) == 0) return true;
        const int lim = u.x0 >> 1, col = u.pn * 256 + wc * 64 + 8 * fq; constexpr float isc = 1.0f / (SH8 * SD8);
#pragma unroll
        for (int ai = 0; ai < 2; ++ai) {
            unsigned tk[4]; u32x4 xv[4][2];
#pragma unroll
            for (int m = 0; m < 4; ++m) { const int r = ai * 128 + wr * 64 + m * 16 + fr; tk[m] = BTOK[u.x1 + r]; }
#pragma unroll
            for (int m = 0; m < 4; ++m)
#pragma unroll
                for (int bj = 0; bj < 2; ++bj) xv[m][bj] = *(const GAS u32x4*)(X1B + (size_t)tk[m] * DM + col + 32 * bj);
#pragma unroll
            for (int m = 0; m < 4; ++m) { const int r = ai * 128 + wr * 64 + m * 16 + fr;
                if (r < lim) {
#pragma unroll
                    for (int bj = 0; bj < 2; ++bj) { const u32x4 x = xv[m][bj]; const f32x4 a = acc[ai][bj][m][0], b = acc[ai][bj][m][1];
                        f32x4 o0, o1; o0[0] = bf_lo(x.x) + a[0] * isc; o0[1] = bf_hi(x.x) + a[1] * isc; o0[2] = bf_lo(x.y) + a[2] * isc; o0[3] = bf_hi(x.y) + a[3] * isc;
                        o1[0] = bf_lo(x.z) + b[0] * isc; o1[1] = bf_hi(x.z) + b[1] * isc; o1[2] = bf_lo(x.w) + b[2] * isc; o1[3] = bf_hi(x.w) + b[3] * isc;
                        GAS f32x4* op = (GAS f32x4*)(out + (size_t)tk[m] * DM + col + 32 * bj); op[0] = o0; op[1] = o1; } } }
        }
        return false;
    }
};
__device__ __forceinline__ void moe_load_buckets(const Frame& F, LAS unsigned* bt0) {
    const unsigned* BCNT = (const unsigned*)(F.ws + WS_CTL) + CW_BCNT;
    if (F.tid < NBK) { const unsigned c = ld_agent(BCNT + F.tid); bt0[64 + F.tid] = c; bt0[32 + F.tid] = (c + 255u) >> 8; }
    LDS_WAIT(); __syncthreads();
    if (F.tid == 0) { unsigned s = 0; for (int b = 0; b < NBK; ++b) { bt0[b] = s; s += bt0[32 + b]; } bt0[NBK] = s; }
    LDS_WAIT(); __syncthreads();
}
__device__ __forceinline__ void moe_load_info(const Frame& F, LAS unsigned* mt0) {
    const unsigned* ECNT = (const unsigned*)(F.ws + WS_CTL) + CW_ECNT;
    if (F.tid < NEXP) mt0[32 + F.tid] = (ld_agent(ECNT + F.tid) + 255u) >> 8;
    LDS_WAIT(); __syncthreads();
    if (F.tid == 0) { unsigned s = 0; for (int e = 0; e < NEXP; ++e) { mt0[e] = s; s += mt0[32 + e]; } mt0[NEXP] = s; }
    LDS_WAIT(); __syncthreads();
}

constexpr int N_PHASES = 9;
__global__ void __launch_bounds__(NWAVES * 64, 2) fwd(Args args) {
    extern __shared__ __attribute__((aligned(16))) unsigned char lds[];
    Frame F;
    F.lds = (LAS unsigned char*)lds;
    F.tid = threadIdx.x; F.lane = F.tid & 63; F.wave = __builtin_amdgcn_readfirstlane(F.tid >> 6);
    F.G = gridDim.x; { const int bx = blockIdx.x; F.vcu = (F.G % 8 == 0) ? (bx % 8) * (F.G / 8) + bx / 8 : bx; }
    F.x = args.in[0]; F.g_mix = args.in[1]; F.w_in = args.in[2]; F.qn_a = args.in[3]; F.kn_a = args.in[4]; F.sinks = args.in[5]; F.qn_b = args.in[6]; F.kn_b = args.in[7];
    F.w_upa = args.in[8]; F.w_upb = args.in[9]; F.w_out = args.in[10]; F.g_ffn = args.in[11]; F.w_rg = args.in[12]; F.w_re = args.in[13]; F.w_ge = args.in[14]; F.w_ue = args.in[15]; F.w_de = args.in[16];
    F.out = args.out; F.ws = args.ws;
    volatile LAS unsigned* MISC = (volatile LAS unsigned*)(F.lds + MISC_OFF);
    for (int u = F.tid; u < (LDS_X_OFF - LDSCTL_OFF) / 4; u += NWAVES * 64) ((LAS unsigned*)(F.lds + LDSCTL_OFF))[u] = 0u;
    __syncthreads();
    gu32* ctl = (gu32*)(F.ws + WS_CTL);
    XcdBarrier bar; bar.bar = (unsigned*)(ctl + CW_BAR); bar.x = 0; bar.st = nullptr;
    const int lo = args.ph_lo, hi = args.ph_hi;
    const bool multi = (hi - lo) > 1;
    if (multi) bar = xcd_barrier_post((unsigned*)(ctl + CW_BAR), MISC + 8);
#define IN(k) (lo <= (k) && (k) < hi)
#define SEAM(k) do { if (IN(k) && IN((k) + 1)) xcd_barrier(bar); } while (0)
    const int cid = (int)blockIdx.x;

    if (IN(0)) { p0_prologue(F); SEAM(0); }
    if (IN(1)) {
        { SchedIn8 S{(const char*)(F.ws + WS_X8), (const char*)(F.ws + WS_WIN8), F.G, cid};
          const float* XS = (const float*)(F.ws + WS_XS); const float* WSC = (const float*)(F.ws + WS_WSC);
          EpiIn8 E{EpiProj{(bf16_t*)(F.ws + WS_PROJ), (float*)(F.ws + WS_KSUM), F.qn_a, F.kn_a, F.qn_b, F.kn_b, XS, WSC}, EpiGate8{(bf16_t*)(F.ws + WS_PROJ), XS, WSC}};
          g8::gemm_phase<EpiIn8, SchedIn8, false, false, true>(F.lds, DM / 2, DM / 2, S, E); }
        { constexpr int NUN = (NTOK / 256) * (INC / 256); const int r = NUN % F.G;
          if (r == 0) convert_moe_gate_up(F, cid, F.G); else if (cid >= r) convert_moe_gate_up(F, cid - r, F.G - r); }
        SEAM(1);
    }
    #if defined(ATTN_NAIVE)
    if (IN(2)) { attn_naive(F); SEAM(2); }
#else
    if (IN(2)) { att::attn_phase(F); SEAM(2); }
#endif
    if (IN(3)) {
        SchedUp S{(const char*)(F.ws + WS_XN), (const char*)(F.ws + WS_WUP), F.G, cid};
        EpiUp E{(const bf16_t*)(F.ws + WS_PROJ), (bf16_t*)(F.ws + WS_MERGED)};
        g8::gemm_phase<EpiUp, SchedUp, false>(F.lds, 1024, 1024, S, E);
        SEAM(3);
    }
    if (IN(4)) {
        SchedTiles S{(const char*)(F.ws + WS_MERGED), (const char*)(F.ws + WS_WOUT), NTOK / 256, DM / 256, DM, F.G, cid};
        EpiOut E{F.x, (bf16_t*)(F.ws + WS_XN), (float*)(F.ws + WS_SS), (unsigned char*)(F.ws + WS_X8)};
        g8::gemm_phase<EpiOut, SchedTiles, false>(F.lds, DM, DM, S, E);
        SEAM(4);
    }
    if (IN(5)) { p5a_route(F); if (IN(5) && IN(7)) xcd_barrier(bar); }
    LAS unsigned* mt0 = (LAS unsigned*)(F.lds + LDS_X_OFF + 1024);
    if (IN(7)) {
        moe_load_info(F, mt0);
        const int jU = (F.G == 256) ? ((((F.vcu & 31) >> 2) << 5) | ((F.vcu >> 5) << 2) | (F.vcu & 3)) : F.vcu;
        SchedMoeUp S{(const char*)(F.ws + WS_X8), (const char*)(F.ws + WS_WGU), (const int*)(F.ws + WS_SL + SL_TOS), mt0, F.G, jU};
        EpiMoeUp E{(const float*)(F.ws + WS_SL + SL_WOS), (const float*)(F.ws + WS_SL + SL_RSOS), (bf16_t*)(F.ws + WS_PROJ)};
        g8::gemm_phase<EpiMoeUp, SchedMoeUp, true, true>(F.lds, DM / 2, DM / 2, S, E);
        { const int r = ((int)mt0[NEXP] * 4) % F.G;
          if (r == 0) convert_moe_down(F, jU, F.G); else if (jU >= r) convert_moe_down(F, jU - r, F.G - r); }
        SEAM(7);
    }
    if (IN(8)) {
        LAS unsigned* bt0 = mt0 + 128;
        moe_load_buckets(F, bt0);
        const int jD = (F.G == 256) ? ((((F.vcu & 31) >> 3) << 6) | ((F.vcu >> 5) << 3) | (F.vcu & 7)) : F.vcu;
        SchedMoeDown S{(const char*)(F.ws + WS_PROJ), (const char*)(F.ws + WS_WD), (const int*)(F.ws + WS_BK + BK_RA), (const int*)(F.ws + WS_BK + BK_RB), bt0, F.G, jD};
        EpiMoeDown E{F.out, (const bf16_t*)(F.ws + WS_XN), (const unsigned*)(F.ws + WS_BK + BK_TOK)};
        g8::gemm_phase<EpiMoeDown, SchedMoeDown, true, true>(F.lds, DEXP / 2, DEXP / 2, S, E);
    }
#undef IN
#undef SEAM
}

extern "C" void kernel_launch(void* const* d_in, const int* in_sizes, int n_in, void* d_out, int out_size, void* d_ws, size_t ws_size, hipStream_t stream) {
    static int grid = 0;
    if (grid == 0) {
        if (n_in != 17 || in_sizes[0] != NTOK * DM || out_size != NTOK * DM || ws_size < WS_END) {
            fprintf(stderr, "kernel_launch: unexpected problem (n_in %d, in0 %d, out %d, ws %zu)\n", n_in, n_in > 0 ? in_sizes[0] : -1, out_size, ws_size); grid = -1; return; }
        int dev = 0, cus = 0, per_cu = 0;
        if (hipGetDevice(&dev) != hipSuccess || hipDeviceGetAttribute(&cus, hipDeviceAttributeMultiprocessorCount, dev) != hipSuccess) { grid = -1; return; }
        if (hipFuncSetAttribute((const void*)fwd, hipFuncAttributeMaxDynamicSharedMemorySize, LDS_BYTES) != hipSuccess) { fprintf(stderr, "kernel_launch: hipFuncSetAttribute failed\n"); grid = -1; return; }
        if (hipOccupancyMaxActiveBlocksPerMultiprocessor(&per_cu, (const void*)fwd, NWAVES * 64, LDS_BYTES) != hipSuccess || per_cu < 1)
            fprintf(stderr, "kernel_launch: occupancy query reports %d workgroups per CU\n", per_cu);
        (void)hipGetLastError();
        grid = cus;
        if (grid != 256) fprintf(stderr, "kernel_launch: %d CUs (built for 256)\n", grid);
    }
    if (grid < 0) return;
    (void)hipMemsetAsync((char*)d_ws + WS_CTL, 0, CTL_ZERO_BYTES, stream);
    Args a{};
    for (int i = 0; i < 17; ++i) a.in[i] = (const float*)d_in[i];
    a.out = (float*)d_out; a.ws = (unsigned char*)d_ws;
#if MK_LAUNCHES == 1
    a.ph_lo = 0; a.ph_hi = N_PHASES;
    hipLaunchKernelGGL(fwd, dim3(grid), dim3(NWAVES * 64), LDS_BYTES, stream, a);
#else
#ifndef PROBE_REP_MASK
#define PROBE_REP_MASK 0
#endif
    for (int p = 0; p < N_PHASES; ++p) { if (p == 6) continue; a.ph_lo = p; a.ph_hi = p + 1;
        for (int rep = 0; rep < 1 + ((PROBE_REP_MASK >> p) & 1); ++rep) hipLaunchKernelGGL(fwd, dim3(grid), dim3(NWAVES * 64), LDS_BYTES, stream, a); }
#endif
}
```

```cpp
#include <hip/hip_runtime.h>
#include <cstdio>
#include <cstdint>

#ifndef MK_LAUNCHES
#define MK_LAUNCHES 1
#endif

#define LAS __attribute__((address_space(3)))
#define GAS __attribute__((address_space(1)))
typedef unsigned short bf16_t;
typedef short bf16x8 __attribute__((ext_vector_type(8)));
typedef float f32x4 __attribute__((ext_vector_type(4)));
typedef float f32x2 __attribute__((ext_vector_type(2)));
typedef unsigned u32x4 __attribute__((ext_vector_type(4)));
typedef unsigned u32x2 __attribute__((ext_vector_type(2)));
typedef GAS unsigned gu32;
#define RLX_AGENT __ATOMIC_RELAXED, __HIP_MEMORY_SCOPE_AGENT

constexpr int DM = 2048, NB = 4, SEQ = 2048, NTOK = NB * SEQ, HD = 64;
constexpr int INC = 8448;
constexpr int QA0 = 0, KA0 = 1024, VA0 = 1152, QB0 = 1280, KB0 = 2304, VB0 = 3328, GA0 = 4352, GB0 = 6400;
constexpr int NEXP = 16, DEXP = 512;
constexpr float EPS = 1e-6f;
constexpr float LOG2E = 1.4426950408889634f;
constexpr float QSCALE = 0.125f * LOG2E;
constexpr int SLOT_CAP = NTOK * 2 + NEXP * 256;

constexpr size_t MiB = 1u << 20;
constexpr size_t WS_CTL = 0, CTL_ZERO_BYTES = 64 * 1024;
constexpr size_t WS_KSUM = 1 * MiB;
constexpr size_t WS_XS = 1 * MiB + 512 * 1024;
constexpr size_t WS_WSC = 1 * MiB + 768 * 1024;
constexpr size_t WS_SS = 2 * MiB;
constexpr size_t WS_RT = 3 * MiB;
constexpr size_t RT_TOKE = 0, RT_TOKW = 64 * 1024, RT_CNT = 128 * 1024, RT_INFO = 160 * 1024, RT_TOS = 192 * 1024, RT_WOS = 320 * 1024, RT_SOT = 448 * 1024, RT_RSTD = 512 * 1024, RT_RSOS = 576 * 1024;
constexpr size_t WS_WIN = 4 * MiB;
constexpr size_t WS_WUP = 37 * MiB;
constexpr size_t WS_WOUT = 45 * MiB;
constexpr size_t WS_WGU = 53 * MiB;
constexpr size_t WS_WD = 117 * MiB;
constexpr size_t WS_XN = 149 * MiB;
constexpr size_t WS_PROJ = 181 * MiB;
constexpr size_t WS_MERGED = 4 * MiB;
constexpr size_t WS_SL = 313 * MiB;
constexpr size_t SL_TOS = 0, SL_WOS = 512 * 1024, SL_RSOS = 1024 * 1024, SL_T2S = 1536 * 1024;
constexpr size_t WS_Y2 = 4 * MiB;
constexpr int NBK = 24, BCAP = 8192;
constexpr int ECAP = 8192;
constexpr size_t WS_GWT = 3 * MiB;
constexpr size_t WS_X8 = 316 * MiB;
constexpr size_t WS_BK = 332 * MiB;
constexpr size_t BK_TOK = 0, BK_RA = 768 * 1024, BK_RB = 1536 * 1024, BK_BYTES = 2304 * 1024;
constexpr size_t WS_END = 335 * MiB;
constexpr float SX8 = 8.f, SW8 = 32.f, SH8 = 16.f, SD8 = 16.f, SXN8 = 8.f, SWI8 = 32.f, SY8 = 64.f;
constexpr int NT_QKV = GA0 / 256;
constexpr size_t WS_WIN8 = WS_WIN;

constexpr int CW_TMO = 0, CW_BAR = 1024, CW_ECNT = 6144, CW_BCNT = 6176;

constexpr int RING_BYTES = 131072;
constexpr int LDSCTL_OFF = RING_BYTES, MISC_OFF = LDSCTL_OFF + 320;
constexpr int LDS_X_OFF = RING_BYTES + 1024;
constexpr int LDS_BYTES = 147456;
constexpr int NWAVES = 8;

#define LDS_WAIT() asm volatile("s_waitcnt lgkmcnt(0)" ::: "memory")
#define VM_WAIT() asm volatile("s_waitcnt vmcnt(0)" ::: "memory")
__device__ __forceinline__ unsigned f2bf(float f) { unsigned u = __builtin_bit_cast(unsigned, f); return (u + 0x7fffu + ((u >> 16) & 1u)) >> 16; }
__device__ __forceinline__ unsigned pk2(float lo, float hi) { return f2bf(lo) | (f2bf(hi) << 16); }
__device__ __forceinline__ float bf_lo(unsigned w) { return __builtin_bit_cast(float, w << 16); }
__device__ __forceinline__ float bf_hi(unsigned w) { return __builtin_bit_cast(float, w & 0xffff0000u); }
__device__ __forceinline__ float wave_sum(float v) {
#pragma unroll
    for (int o = 1; o < 64; o <<= 1) v += __shfl_xor(v, o);
    return v;
}
typedef int i32x4 __attribute__((ext_vector_type(4)));
typedef int i32x8 __attribute__((ext_vector_type(8)));
__device__ __forceinline__ unsigned pk8(float a, float b, float c, float d) {
    int w = __builtin_amdgcn_cvt_pk_fp8_f32(a, b, 0, false); w = __builtin_amdgcn_cvt_pk_fp8_f32(c, d, w, true); return (unsigned)w; }
__device__ __forceinline__ float wave_max(float v) {
#pragma unroll
    for (int o = 1; o < 64; o <<= 1) v = fmaxf(v, __shfl_xor(v, o));
    return v;
}
__device__ __forceinline__ unsigned pki8(float a, float b, float c, float d) {
    const int ia = (int)__builtin_rintf(a), ib = (int)__builtin_rintf(b), ic = (int)__builtin_rintf(c), id = (int)__builtin_rintf(d);
    return (unsigned)(ia & 255) | ((unsigned)(ib & 255) << 8) | ((unsigned)(ic & 255) << 16) | ((unsigned)id << 24); }
__device__ __forceinline__ float amax4(float m, const f32x4& v) { return fmaxf(fmaxf(m, fmaxf(fabsf(v[0]), fabsf(v[1]))), fmaxf(fabsf(v[2]), fabsf(v[3]))); }
#define NT_LD4(p) __builtin_nontemporal_load((const GAS f32x4*)(p))
__device__ __forceinline__ unsigned ld_agent(const unsigned* p) { return __hip_atomic_load(p, RLX_AGENT); }
__device__ __forceinline__ float ld_agent_f(const float* p) { return __builtin_bit_cast(float, __hip_atomic_load((const unsigned*)p, RLX_AGENT)); }

namespace g8 {
constexpr int BM = 256, BK = 64, HALF = 128, HTB = HALF * BK * 2, NXCD = 8, WGM = 4;
__host__ __device__ __forceinline__ int lds_byte(int r, int c) { const int st = (r >> 4) * 2 + (c >> 5), rr = r & 15, cc = c & 31, ob = rr * 64 + cc * 2; return st * 1024 + (ob ^ (((ob >> 9) & 1) << 5)); }
__host__ __device__ __forceinline__ void stage_rc(int b, int& R, int& C) { const int st = b / 1024, sb = b % 1024, swz = sb ^ (((sb >> 9) & 1) << 5); R = (st >> 1) * 16 + swz / 64; C = (st & 1) * 32 + (swz % 64) / 2; }

struct Unit { const char* a; const char* b; const int* rows; int nkt; int pm, pn, x0, x1; };

__device__ __forceinline__ bool tile_order(int nM, int nN, int G, int c, int i, int& pm, int& pn) {
    const int nwg = nM * nN; const long L = (long)i * G + c; if (L >= nwg) return false;
    int wgid = (int)L; { const int q = nwg / NXCD, r = nwg % NXCD, xcd = wgid % NXCD, off = wgid / NXCD; wgid = (xcd < r ? xcd * (q + 1) : r * (q + 1) + (xcd - r) * q) + off; }
    const int nig = WGM * nN, gid = wgid / nig, fm = gid * WGM, gsz = (nM - fm) < WGM ? (nM - fm) : WGM;
    pm = fm + ((wgid % nig) % gsz); pn = (wgid % nig) / gsz; return true;
}

template <class Epi, class Sched, bool GATHER, bool FP8 = false, bool I8 = false>
__device__ __forceinline__ void gemm_phase(LAS unsigned char* lds, const int lda, const int ldb, const Sched& S, const Epi& E) {
    const int tid = threadIdx.x, wid = __builtin_amdgcn_readfirstlane(tid >> 6), lane = tid & 63, wr = wid >> 2, wc = wid & 3, fr = lane & 15, fq = lane >> 4;
    int Rr[2], Cc[2];
#pragma unroll
    for (int i = 0; i < 2; ++i) stage_rc(tid * 16 + i * 8192, Rr[i], Cc[i]);
    unsigned voffB[2], voffA[2];
#pragma unroll
    for (int i = 0; i < 2; ++i) { voffB[i] = (unsigned)(Rr[i] * ldb + Cc[i]) * 2u; voffA[i] = (unsigned)(Rr[i] * lda + Cc[i]) * 2u; }
    const size_t kstep = (size_t)(BK * 2);
    const size_t hstepA = (size_t)HALF * lda * 2, hstepB = (size_t)HALF * ldb * 2;
    const unsigned ldsw = (unsigned)wid * 1024u;
    const int aoff = lds_byte(wr * 64 + fr, fq * 8), boff = lds_byte(wc * 32 + fr, fq * 8);
    const int aoff8 = lds_byte(wr * 64 + fr, 16 * (fq & 1)) + (fq >> 1) * 1024, boff8 = lds_byte(wc * 32 + fr, 16 * (fq & 1)) + (fq >> 1) * 1024;
#define G8_SA(b, h) (((b) * 2 + (h)) * HTB)
#define G8_SB(b, h) ((4 + (b) * 2 + (h)) * HTB)
#define G8_STAGE(bufoff, gbase, voff) do { _Pragma("unroll") for (int _i = 0; _i < 2; ++_i) \
        __builtin_amdgcn_global_load_lds((const unsigned*)((const char*)(gbase) + (voff)[_i]), (LAS unsigned*)(lds + (bufoff) + ldsw + _i * 8192), 16, 0, 0); } while (0)
#define G8_STAGE_A(bufoff, gbase, h, va) do { if (GATHER) { G8_STAGE(bufoff, gbase, (va)[h]); } else { G8_STAGE(bufoff, (gbase) + (h) * hstepA, voffA); } } while (0)
#define G8_STAGE_B(bufoff, gbase, h) G8_STAGE(bufoff, (gbase) + (h) * hstepB, voffB)
#define G8_LD8(p) (*(const LAS i32x8*)(p))
#define G8_LDA(dst, b, h) do { _Pragma("unroll") for (int m = 0; m < 4; ++m) { if (FP8) dst##8[m] = G8_LD8(lds + G8_SA(b, h) + aoff8 + m * 2048); else { _Pragma("unroll") for (int k = 0; k < 2; ++k) dst[m][k] = *(const LAS bf16x8*)(lds + G8_SA(b, h) + aoff + m * 2048 + k * 1024); } } } while (0)
#define G8_LDB(dst, b, h) do { _Pragma("unroll") for (int n = 0; n < 2; ++n) { if (FP8) dst##8[n] = G8_LD8(lds + G8_SB(b, h) + boff8 + n * 2048); else { _Pragma("unroll") for (int k = 0; k < 2; ++k) dst[n][k] = *(const LAS bf16x8*)(lds + G8_SB(b, h) + boff + n * 2048 + k * 1024); } } } while (0)
#define G8_CAT(x0, x1) __builtin_shufflevector(__builtin_bit_cast(i32x4, x0), __builtin_bit_cast(i32x4, x1), 0, 1, 2, 3, 4, 5, 6, 7)
#define G8_MMA(ai, bj, At, Bt) do { __builtin_amdgcn_s_setprio(1); _Pragma("unroll") for (int m = 0; m < 4; ++m) _Pragma("unroll") for (int n = 0; n < 2; ++n) { \
        if (FP8) asm volatile("v_mfma_scale_f32_16x16x128_f8f6f4 %0, %1, %2, %0, %3, %3 op_sel_hi:[0,0,0]" : "+v"(acc[ai][bj][m][n]) : "v"(Bt##8[n]), "v"(At##8[m]), "v"(one8));     \
        else if (I8) { _Pragma("unroll") for (int k = 0; k < 2; ++k) acc[ai][bj][m][n] = __builtin_bit_cast(f32x4, __builtin_amdgcn_mfma_i32_16x16x64_i8(__builtin_bit_cast(i32x4, Bt[n][k]), __builtin_bit_cast(i32x4, At[m][k]), __builtin_bit_cast(i32x4, acc[ai][bj][m][n]), 0, 0, 0)); }     \
        else { _Pragma("unroll") for (int k = 0; k < 2; ++k) acc[ai][bj][m][n] = __builtin_amdgcn_mfma_f32_16x16x32_bf16(Bt[n][k], At[m][k], acc[ai][bj][m][n], 0, 0, 0); } } \
        __builtin_amdgcn_s_setprio(0); } while (0)
#define G8_WAIT_V(n) asm volatile("s_waitcnt vmcnt(" #n ")" ::: "memory")
#define G8_WAIT_L(n) asm volatile("s_waitcnt lgkmcnt(" #n ")" ::: "memory")
#define G8_BAR __builtin_amdgcn_s_barrier()
#define G8_SCHED __builtin_amdgcn_sched_barrier(0)
#define G8_AOFF(dst, u) do { int _t = tid; asm volatile("" : "+v"(_t)); _Pragma("unroll") for (int _i = 0; _i < 2; ++_i) { int _R, _C; stage_rc(_t * 16 + _i * 8192, _R, _C); \
        _Pragma("unroll") for (int _h = 0; _h < 2; ++_h) { const int _r = (int)ld_agent((const unsigned*)((u).rows + _h * HALF + _R)); dst[_h][_i] = (unsigned)(_r * lda + _C) * 2u; } } } while (0)
    Unit cur, nxt; int ui = 0;
    if (!S.next(0, cur)) return;
    unsigned cva[2][2], nva[2][2];
    if (GATHER) { G8_AOFF(cva, cur); }
    f32x4 acc[2][2][4][2];
#pragma unroll
    for (int a = 0; a < 2; ++a)
#pragma unroll
        for (int b = 0; b < 2; ++b)
#pragma unroll
            for (int m = 0; m < 4; ++m)
#pragma unroll
                for (int n = 0; n < 2; ++n) acc[a][b][m][n] = (f32x4){0.f, 0.f, 0.f, 0.f};
    bf16x8 At[4][2], B0[2][2], B1[2][2]; i32x8 At8[4], B08[2], B18[2]; const int one8 = 0x7f7f7f7f;
    const char* cA = cur.a; const char* cB = cur.b;
    G8_STAGE_B(G8_SB(0, 0), cB, 0); G8_STAGE_B(G8_SB(0, 1), cB, 1); G8_STAGE_A(G8_SA(0, 0), cA, 0, cva); G8_STAGE_A(G8_SA(0, 1), cA, 1, cva);
    if (wr == 1) G8_BAR;
    G8_WAIT_V(2); G8_BAR;
    G8_STAGE_B(G8_SB(1, 0), cB + kstep, 0); G8_STAGE_A(G8_SA(1, 0), cA + kstep, 0, cva); G8_STAGE_B(G8_SB(1, 1), cB + kstep, 1);
    G8_WAIT_V(6); G8_BAR;
    for (;;) {
        const bool has_next = S.next(ui + 1, nxt);
        const char* nA = has_next ? nxt.a : cA; const char* nB = has_next ? nxt.b : cB;
        if (GATHER) { if (has_next) { G8_AOFF(nva, nxt); } else {
#pragma unroll
            for (int h = 0; h < 2; ++h) { nva[h][0] = cva[h][0]; nva[h][1] = cva[h][1]; } } }
        const int nt = cur.nkt;
        for (int t = 0; t < nt; t += 2) {
            const bool last = (t == nt - 2);
            const char* a1 = cA + (size_t)(t + 1) * kstep;
            const char* a2 = last ? nA : cA + (size_t)(t + 2) * kstep; const char* b2 = last ? nB : cB + (size_t)(t + 2) * kstep;
            const char* a3 = a2 + kstep; const char* b3 = b2 + kstep;
            unsigned va2[2][2];
#pragma unroll
            for (int h = 0; h < 2; ++h)
#pragma unroll
                for (int i = 0; i < 2; ++i) va2[h][i] = (GATHER && last) ? nva[h][i] : cva[h][i];
            G8_LDB(B0, 0, 0); G8_LDB(B1, 0, 1); G8_SCHED; G8_LDA(At, 0, 0); G8_STAGE_A(G8_SA(1, 1), a1, 1, cva);
            G8_WAIT_V(8); G8_WAIT_L(0); G8_BAR; G8_MMA(0, 0, At, B0); G8_MMA(0, 1, At, B1); G8_BAR; G8_SCHED;
            G8_LDA(At, 0, 1); G8_STAGE_B(G8_SB(0, 0), b2, 0); G8_STAGE_B(G8_SB(0, 1), b2, 1); G8_STAGE_A(G8_SA(0, 0), a2, 0, va2);
            G8_WAIT_V(8); G8_WAIT_L(0); G8_BAR; G8_MMA(1, 0, At, B0); G8_MMA(1, 1, At, B1); G8_BAR; G8_SCHED;
            G8_LDB(B0, 1, 0); G8_LDB(B1, 1, 1); G8_SCHED; G8_LDA(At, 1, 0); G8_STAGE_A(G8_SA(0, 1), a2, 1, va2);
            G8_WAIT_V(8); G8_WAIT_L(0); G8_BAR; G8_MMA(0, 0, At, B0); G8_MMA(0, 1, At, B1); G8_BAR; G8_SCHED;
            G8_LDA(At, 1, 1); G8_STAGE_B(G8_SB(1, 0), b3, 0); G8_STAGE_B(G8_SB(1, 1), b3, 1); G8_STAGE_A(G8_SA(1, 0), a3, 0, va2);
            G8_WAIT_V(8); G8_WAIT_L(0); G8_BAR; G8_MMA(1, 0, At, B0); G8_MMA(1, 1, At, B1); G8_BAR; G8_SCHED;
        }
        if (FP8) asm volatile("s_nop 15\n\ts_nop 15" ::: "memory");
        if (wr == 0) G8_BAR;
        const bool keep = E(acc, cur, wr, wc, fr, fq);
        if (!has_next) break;
        if (!keep) {
#pragma unroll
            for (int a = 0; a < 2; ++a)
#pragma unroll
                for (int b = 0; b < 2; ++b)
#pragma unroll
                    for (int m = 0; m < 4; ++m)
#pragma unroll
                        for (int n = 0; n < 2; ++n) acc[a][b][m][n] = (f32x4){0.f, 0.f, 0.f, 0.f};
        }
        cur = nxt; cA = nA; cB = nB; ++ui;
        if (GATHER) {
#pragma unroll
            for (int h = 0; h < 2; ++h) { cva[h][0] = nva[h][0]; cva[h][1] = nva[h][1]; } }
        if (wr == 1) G8_BAR;
    }
    G8_WAIT_V(0);
    G8_BAR;
#undef G8_SA
#undef G8_SB
#undef G8_STAGE
#undef G8_STAGE_A
#undef G8_STAGE_B
#undef G8_LDA
#undef G8_LD8
#undef G8_LDB
#undef G8_MMA
#undef G8_CAT
#undef G8_WAIT_V
#undef G8_WAIT_L
#undef G8_BAR
#undef G8_SCHED
#undef G8_AOFF
}
}

#define XB_TMO      128
#define XB_XCNT(j)  (256  + 64 * (j))
#define XB_XSUB(j)  (1280 + 64 * (j))
#define XB_XGEN(j)  (2304 + 64 * (j))
#define XB_TOP      3328
#define XB_TOPGEN   3392
#define XCD_BAR_WORDS 3456
#define XB_SPIN_CAP (1u << 18)
__device__ __forceinline__ unsigned xb_ld(unsigned* p)              { return __hip_atomic_load(p, __ATOMIC_RELAXED, __HIP_MEMORY_SCOPE_AGENT); }
__device__ __forceinline__ unsigned xb_add(unsigned* p, unsigned v) { return __hip_atomic_fetch_add(p, v, __ATOMIC_RELAXED, __HIP_MEMORY_SCOPE_AGENT); }
__device__ __forceinline__ unsigned xb_xcc_id() { return (unsigned)__builtin_amdgcn_s_getreg((3 << 11) | 20) & 0xFu; }
#define XB_SPIN(cond, bar) do { unsigned _sp = 0; while (cond) { __builtin_amdgcn_s_sleep(1); \
    if ((++_sp & 255u) == 0u) { if (xb_ld(&(bar)[XB_TMO])) break; if (_sp > XB_SPIN_CAP) { atomicAdd(&(bar)[XB_TMO], 1u); break; } } } } while (0)
struct XcdBarrier { unsigned* bar; unsigned x; volatile LAS unsigned* st; };
__device__ __forceinline__ XcdBarrier xcd_barrier_post(unsigned* bar, volatile LAS unsigned* st) {
    XcdBarrier b; b.bar = bar; b.x = xb_xcc_id(); b.st = st;
    if (threadIdx.x == 0) (void)xb_add(&bar[XB_XCNT(b.x)], 1u);
    return b;
}
__device__ __forceinline__ void xcd_barrier_complete(unsigned* bar, unsigned x, unsigned& nloc, unsigned& nx) {
    const unsigned G = gridDim.x * gridDim.y * gridDim.z;
    unsigned sum, cnt, mine, sp = 0u;
    for (;;) {
        sum = 0u; cnt = 0u; mine = 0u;
#pragma unroll
        for (unsigned j = 0; j < 16; ++j) { const unsigned c = xb_ld(&bar[XB_XCNT(j)]); sum += c; cnt += (c > 0u) ? 1u : 0u; mine = (j == x) ? c : mine; }
        if (sum == G) break;
        __builtin_amdgcn_s_sleep(1);
        if ((++sp & 255u) == 0u) { if (xb_ld(&bar[XB_TMO])) break; if (sp > XB_SPIN_CAP) { atomicAdd(&bar[XB_TMO], 1u); break; } }
    }
    nloc = mine > 0u ? mine : 1u; nx = cnt > 0u ? cnt : 1u;
}
__device__ __forceinline__ void xcd_barrier(const XcdBarrier& b) {
    asm volatile("s_waitcnt vmcnt(0)" ::: "memory");
    __syncthreads();
    if (threadIdx.x == 0) {
        unsigned* bar = b.bar;
        __builtin_amdgcn_s_waitcnt(0);
        unsigned nloc = b.st[0], nx = b.st[1];
        if (nloc == 0u) { xcd_barrier_complete(bar, b.x, nloc, nx); b.st[0] = nloc; b.st[1] = nx; }
        const unsigned old = xb_add(&bar[XB_XSUB(b.x)], 1u);
        const unsigned gen = old / nloc;
        if (old + 1u == (gen + 1u) * nloc) {
            __builtin_amdgcn_fence(__ATOMIC_RELEASE, "agent");
            asm volatile("s_waitcnt vmcnt(0)" ::: "memory");
            const unsigned og = xb_add(&bar[XB_TOP], 1u);
            const unsigned tg = og / nx;
            if (og + 1u == (tg + 1u) * nx) xb_add(&bar[XB_TOPGEN], 1u);
            else XB_SPIN(xb_ld(&bar[XB_TOPGEN]) == tg, bar);
            __builtin_amdgcn_fence(__ATOMIC_ACQUIRE, "agent");
            xb_add(&bar[XB_XGEN(b.x)], 1u);
            asm volatile("s_waitcnt vmcnt(0)" ::: "memory");
        } else {
            XB_SPIN(xb_ld(&bar[XB_XGEN(b.x)]) == gen, bar);
            __builtin_amdgcn_fence(__ATOMIC_ACQUIRE, "agent");
            asm volatile("s_waitcnt vmcnt(0)" ::: "memory");
        }
    }
    __syncthreads();
}

struct Args { const float* in[17]; float* out; unsigned char* ws; int ph_lo, ph_hi; };

struct Frame {
    LAS unsigned char* lds;
    int tid, lane, wave, vcu, G;
    const float *x, *g_mix, *w_in, *qn_a, *kn_a, *sinks, *qn_b, *kn_b, *w_upa, *w_upb, *w_out, *g_ffn, *w_rg, *w_re, *w_ge, *w_ue, *w_de;
    float* out; unsigned char* ws;
};

__device__ __forceinline__ int perm_in(int j) { return 16 * ((j >> 2) & 1) + 4 * (j >> 3) + (j & 3); }

struct CvItem { const float* src; bf16_t* dst; int ldw, ldt; const float* gk; float sc8; };
__device__ __forceinline__ void cv_load(f32x4 (&v)[8], const CvItem& it, int lane) {
#pragma unroll
    for (int j = 0; j < 8; ++j) v[j] = NT_LD4(it.src + (size_t)((lane >> 3) + 8 * j) * it.ldw + 4 * (lane & 7));
    if (it.gk) {
#pragma unroll
        for (int j = 0; j < 8; ++j) v[j] = v[j] * it.gk[(lane >> 3) + 8 * j]; }
    if (it.sc8 != 0.f) {
#pragma unroll
        for (int j = 0; j < 8; ++j) v[j] = v[j] * it.sc8; }
}
__device__ __forceinline__ void cv_to_lds(const f32x4 (&v)[8], LAS float* scr, int lane) {
#pragma unroll
    for (int j = 0; j < 8; ++j) { LAS float* d = scr + ((lane >> 3) + 8 * j) * 33 + 4 * (lane & 7); d[0] = v[j][0]; d[1] = v[j][1]; d[2] = v[j][2]; d[3] = v[j][3]; }
}
__device__ __forceinline__ void cv_store(const CvItem& it, const LAS float* scr, int lane) {
    const int c = lane & 7;
    if (it.sc8 != 0.f) {
#pragma unroll
        for (int j = 0; j < 4; ++j) { const int n = (lane >> 3) + 8 * j; const LAS float* s = scr + (8 * c) * 33 + n;
            u32x2 o; o.x = pk8(s[0 * 33], s[1 * 33], s[2 * 33], s[3 * 33]); o.y = pk8(s[4 * 33], s[5 * 33], s[6 * 33], s[7 * 33]);
            *(GAS u32x2*)((unsigned char*)it.dst + (size_t)perm_in(n) * it.ldt + 8 * c) = o; }
        return; }
#pragma unroll
    for (int j = 0; j < 4; ++j) { const int n = (lane >> 3) + 8 * j; const LAS float* s = scr + (8 * c) * 33 + n;
        u32x4 o; o.x = pk2(s[0 * 33], s[1 * 33]); o.y = pk2(s[2 * 33], s[3 * 33]); o.z = pk2(s[4 * 33], s[5 * 33]); o.w = pk2(s[6 * 33], s[7 * 33]);
        *(GAS u32x4*)(it.dst + (size_t)perm_in(n) * it.ldt + 8 * c) = o; }
}
template <class Dec> __device__ __forceinline__ void convert_list(const Dec& dec, int gw, int NGW, int N, LAS float* scr, int lane) {
    if (gw >= N) return;
    f32x4 v[8]; CvItem cur = dec(gw); cv_load(v, cur, lane);
    for (int it = gw; it < N; it += NGW) {
        cv_to_lds(v, scr, lane);
        const int nx = it + NGW; CvItem nxt = cur; if (nx < N) { nxt = dec(nx); cv_load(v, nxt, lane); }
        LDS_WAIT(); asm volatile("" ::: "memory");
        cv_store(cur, scr, lane);
        LDS_WAIT(); asm volatile("" ::: "memory");
        cur = nxt;
    }
}
__device__ __forceinline__ int std_row0(int n0) { return (n0 & ~255) + 128 * ((n0 >> 5) & 1) + 32 * ((n0 >> 6) & 3); }

__device__ __forceinline__ void convert_w_in_i8(const Frame& F, int nb) {
    LAS float* scr = (LAS float*)(F.lds + F.wave * 16384);
    volatile LAS float* red = (volatile LAS float*)(F.lds + 12288);
    const int lane = F.lane, w = F.wave;
    const float* src = F.w_in + (size_t)(256 * w + (lane >> 3)) * INC + 32 * nb + 4 * (lane & 7);
    f32x4 v[4][8];
#pragma unroll
    for (int it = 0; it < 4; ++it)
#pragma unroll
        for (int j = 0; j < 8; ++j) v[it][j] = NT_LD4(src + (size_t)(64 * it + 8 * j) * INC);
    float am = 0.f;
#pragma unroll
    for (int it = 0; it < 4; ++it)
#pragma unroll
        for (int j = 0; j < 8; ++j) am = amax4(am, v[it][j]);
    am = wave_max(am);
    __syncthreads();
    if (lane == 0) red[w] = am;
    __syncthreads();
    float gmx = red[0];
#pragma unroll
    for (int i = 1; i < NWAVES; ++i) gmx = fmaxf(gmx, red[i]);
    const float sc = gmx > 0.f ? 127.f / gmx : 0.f;
    if (F.tid == 0) ((float*)(F.ws + WS_WSC))[nb] = gmx * (1.f / 127.f);
    int row0;
    if (32 * nb >= GA0) { const int n1 = 32 * nb - GA0, isb = n1 >> 11, mc0 = n1 & (DM - 1); row0 = GA0 + (mc0 >> 7) * 256 + 128 * isb + 32 * ((mc0 >> 5) & 3); }
    else row0 = std_row0(32 * nb);
    unsigned char* dst = F.ws + WS_WIN8 + (size_t)row0 * DM + 256 * w;
    const int c = lane & 7;
#pragma unroll
    for (int it = 0; it < 4; ++it) {
#pragma unroll
        for (int j = 0; j < 8; ++j) { LAS float* d = scr + ((lane >> 3) + 8 * j) * 33 + 4 * c; const f32x4 q = v[it][j] * sc; d[0] = q[0]; d[1] = q[1]; d[2] = q[2]; d[3] = q[3]; }
        LDS_WAIT(); asm volatile("" ::: "memory");
#pragma unroll
        for (int j = 0; j < 4; ++j) { const int n = (lane >> 3) + 8 * j; const LAS float* sp = scr + (8 * c) * 33 + n;
            u32x2 o; o.x = pki8(sp[0 * 33], sp[1 * 33], sp[2 * 33], sp[3 * 33]); o.y = pki8(sp[4 * 33], sp[5 * 33], sp[6 * 33], sp[7 * 33]);
            *(GAS u32x2*)(dst + 64 * it + (size_t)perm_in(n) * DM + 8 * c) = o; }
        LDS_WAIT(); asm volatile("" ::: "memory");
    }
}

__device__ __forceinline__ void p0_prologue(const Frame& F) {
    LAS float* scr = (LAS float*)(F.lds + F.wave * 16384);
    bf16_t* Wup_t = (bf16_t*)(F.ws + WS_WUP); bf16_t* Wout_t = (bf16_t*)(F.ws + WS_WOUT);
    constexpr int NGRP = INC / 32;
    for (int nb = F.vcu; nb < NGRP; nb += F.G) convert_w_in_i8(F, nb);
    const int nheavy = (F.G < NGRP && 2 * (NGRP % F.G) <= F.G) ? NGRP % F.G : 0;
    if (F.vcu >= nheavy) {
    const int gw = (F.vcu - nheavy) * NWAVES + F.wave, NGW = (F.G - nheavy) * NWAVES;
    constexpr int I_UP = (1024 / 64) * (DM / 32);
    constexpr int I_OUT = (DM / 64) * (DM / 32);
    constexpr int NITEMS = 2 * I_UP + I_OUT;
    struct Dec0 { const float *w_upa, *w_upb, *w_out; bf16_t *Wup_t, *Wout_t;
        __device__ __forceinline__ CvItem operator()(int r) const {
            if (r < 2 * I_UP) { const int half = r / I_UP; r -= half * I_UP; const int nblk = DM / 32, kb = r / nblk, nb = r % nblk;
                return CvItem{(half ? w_upb : w_upa) + (size_t)(64 * kb) * DM + 32 * nb, Wup_t + (size_t)half * DM * 1024 + (size_t)std_row0(32 * nb) * 1024 + 64 * kb, DM, 1024, nullptr, 0.f}; } r -= 2 * I_UP;
            const int nblk = DM / 32, kb = r / nblk, nb = r % nblk; return CvItem{w_out + (size_t)(64 * kb) * DM + 32 * nb, Wout_t + (size_t)std_row0(32 * nb) * DM + 64 * kb, DM, DM, nullptr, 0.f}; } };
    convert_list(Dec0{F.w_upa, F.w_upb, F.w_out, Wup_t, Wout_t}, gw, NGW, NITEMS, scr, F.lane);
    f32x4 gm[8];
#pragma unroll
    for (int j = 0; j < 8; ++j) gm[j] = ((const GAS f32x4*)F.g_mix)[F.lane + 64 * j];
    for (int m = gw; m < NTOK; m += NGW) {
        const GAS f32x4* xr = (const GAS f32x4*)(F.x + (size_t)m * DM) + F.lane;
        f32x4 v[8]; float s = 0.f;
#pragma unroll
        for (int j = 0; j < 8; ++j) { v[j] = NT_LD4(xr + 64 * j); s += (v[j].x * v[j].x + v[j].y * v[j].y) + (v[j].z * v[j].z + v[j].w * v[j].w); }
        const float rstd = 1.0f / sqrtf(wave_sum(s) * (1.f / DM) + EPS);
        float am = 0.f;
#pragma unroll
        for (int j = 0; j < 8; ++j) { v[j] = v[j] * rstd * gm[j]; am = amax4(am, v[j]); }
        am = wave_max(am);
        const float sc = am > 0.f ? 127.f / am : 0.f;
        if (F.lane == 0) ((float*)(F.ws + WS_XS))[m] = am * (1.f / 127.f);
#pragma unroll
        for (int j = 0; j < 8; ++j) { const f32x4 y = v[j] * sc; ((GAS unsigned*)(F.ws + WS_X8 + (size_t)m * DM))[F.lane + 64 * j] = pki8(y.x, y.y, y.z, y.w); }
    }
    }
    { bf16_t* GWT = (bf16_t*)(F.ws + WS_GWT);
      for (int idx = F.vcu * 512 + F.tid; idx < 32 * DM; idx += F.G * 512) { const int j = idx >> 11, d = idx & (DM - 1); float v = 0.f;
          if (j < 4) v = F.w_rg[d * 4 + j]; else if (j < 20) v = F.w_re[((size_t)((j - 4) >> 2) * DM + d) * 4 + ((j - 4) & 3)];
          GWT[idx] = (bf16_t)f2bf(v * F.g_ffn[d]); } }
    { GAS u32x4* z = (GAS u32x4*)(F.ws + WS_SL); for (int i = F.vcu * 512 + F.tid; i < (int)(2 * MiB / 16); i += F.G * 512) z[i] = (u32x4){0u, 0u, 0u, 0u}; }
    { GAS u32x4* z = (GAS u32x4*)(F.ws + WS_BK); for (int i = F.vcu * 512 + F.tid; i < (int)(BK_BYTES / 16); i += F.G * 512) z[i] = (u32x4){0u, 0u, 0u, 0u}; }
    float* KS = (float*)(F.ws + WS_KSUM);
    for (int i = F.vcu * 512 + F.tid; i < NB * 16 * 8 * 64; i += F.G * 512) KS[i] = 0.f;
}

struct CvBlock { const float* src; unsigned char* dst; const float* gk; int kind, e, isup, nblk; };
template <class Dec> __device__ __forceinline__ void convert_blocks_fp8(const Frame& F, const Dec& dec, int wg, int nwg, int nblocks, int ldw, int ldt, float sc) {
    if (wg >= nblocks) return;
    LAS unsigned char* T = F.lds;
    const int lane = F.lane, w = F.wave;
    f32x4 v[16]; float gl;
    CvBlock cur = dec(wg);
#define CVB_LOAD(blk) do { const float* _s = (blk).src + (size_t)(16 * w) * ldw + 4 * lane; _Pragma("unroll") for (int j = 0; j < 16; ++j) v[j] = NT_LD4(_s + (size_t)j * ldw); \
        gl = (blk).gk ? (blk).gk[16 * w + (lane & 15)] * sc : sc; } while (0)
    CVB_LOAD(cur);
    for (int it = wg; it < nblocks; it += nwg) {
        const int sw = 16 * (lane & 7);
#pragma unroll
        for (int q = 0; q < 4; ++q) {
            const float g0 = __builtin_bit_cast(float, __builtin_amdgcn_readlane(__builtin_bit_cast(int, gl), 4 * q)), g1 = __builtin_bit_cast(float, __builtin_amdgcn_readlane(__builtin_bit_cast(int, gl), 4 * q + 1)),
                        g2 = __builtin_bit_cast(float, __builtin_amdgcn_readlane(__builtin_bit_cast(int, gl), 4 * q + 2)), g3 = __builtin_bit_cast(float, __builtin_amdgcn_readlane(__builtin_bit_cast(int, gl), 4 * q + 3));
#pragma unroll
            for (int i = 0; i < 4; ++i) *(LAS unsigned*)(T + (4 * lane + i) * 128 + ((16 * w + 4 * q) ^ sw)) = pk8(v[4 * q][i] * g0, v[4 * q + 1][i] * g1, v[4 * q + 2][i] * g2, v[4 * q + 3][i] * g3);
        }
        const int nx = it + nwg; CvBlock nxt = cur; if (nx < nblocks) { nxt = dec(nx); CVB_LOAD(nxt); }
        LDS_WAIT(); asm volatile("" ::: "memory"); __builtin_amdgcn_s_barrier(); asm volatile("" ::: "memory");
#pragma unroll
        for (int r = 0; r < 4; ++r) { const int n = 32 * w + 8 * r + (lane >> 3), c = lane & 7;
            const u32x4 d = *(const LAS u32x4*)(T + n * 128 + ((16 * c) ^ (16 * ((n >> 2) & 7))));
            int row; if (cur.kind == 0) { const int hc = 256 * cur.nblk + n; row = (hc >> 7) * 256 + 128 * cur.isup + 32 * ((hc >> 5) & 3) + perm_in(hc & 31); } else { const int col = 256 * cur.nblk + n; row = std_row0(col & ~31) + perm_in(col & 31); }
            *(GAS u32x4*)(cur.dst + (size_t)row * ldt + 16 * c) = d; }
        LDS_WAIT(); asm volatile("" ::: "memory"); __builtin_amdgcn_s_barrier(); asm volatile("" ::: "memory");
        cur = nxt;
    }
#undef CVB_LOAD
}
__device__ __forceinline__ void convert_moe_gate_up(const Frame& F, int wg, int nwg) {
    struct Dec { const float *w_ge, *w_ue, *g_ffn; unsigned char* Wgu;
        __device__ __forceinline__ CvBlock operator()(int r) const { const int nblk = r & 1, kb = (r >> 1) & 15, e = (r >> 5) & 15, isup = r >> 9;
            return CvBlock{(isup ? w_ue : w_ge) + (size_t)e * DM * DEXP + (size_t)(128 * kb) * DEXP + 256 * nblk, Wgu + (size_t)e * 1024 * DM + 128 * kb, g_ffn + 128 * kb, 0, e, isup, nblk}; } };
    convert_blocks_fp8(F, Dec{F.w_ge, F.w_ue, F.g_ffn, F.ws + WS_WGU}, wg, nwg, 2 * NEXP * 16 * 2, DEXP, DM, SW8);
}
__device__ __forceinline__ void convert_moe_down(const Frame& F, int wg, int nwg) {
    struct Dec { const float* w_de; unsigned char* Wd;
        __device__ __forceinline__ CvBlock operator()(int r) const { const int nblk = r & 7, kb = (r >> 3) & 3, e = r >> 5;
            return CvBlock{w_de + (size_t)e * DEXP * DM + (size_t)(128 * kb) * DM + 256 * nblk, Wd + (size_t)e * DM * DEXP + 128 * kb, nullptr, 1, e, 0, nblk}; } };
    convert_blocks_fp8(F, Dec{F.w_de, F.ws + WS_WD}, wg, nwg, NEXP * 4 * 8, DM, DEXP, SD8);
}

struct SchedTiles {
    const char* A; const char* Bt; int nM, nN, K, G, c;
    __device__ __forceinline__ bool next(int i, g8::Unit& u) const {
        int pm, pn; if (!g8::tile_order(nM, nN, G, c, i, pm, pn)) return false;
        u.a = A + (size_t)pm * 256 * K * 2; u.b = Bt + (size_t)pn * 256 * K * 2; u.rows = nullptr; u.nkt = K / 64; u.pm = pm; u.pn = pn; u.x0 = 0; u.x1 = 0; return true;
    }
};
struct SchedIn8 {
    const char* A; const char* Bt; int G, c;
    __device__ __forceinline__ bool next(int i, g8::Unit& u) const {
        int pm, pn; if (!g8::tile_order(NTOK / 256, INC / 256, G, c, i, pm, pn)) return false;
        u.a = A + (size_t)pm * 256 * DM; u.b = Bt + (size_t)pn * 256 * DM; u.rows = nullptr; u.nkt = DM / 128; u.pm = pm; u.pn = pn; u.x0 = 0; u.x1 = 0; return true;
    }
};
struct EpiGate8 {
    bf16_t* P; const float* XS; const float* WSC;
    __device__ __forceinline__ bool operator()(f32x4 (&acc)[2][2][4][2], const g8::Unit& u, int wr, int wc, int fr, int fq) const {
        const int t = u.pn - NT_QKV, mcol = t * 128 + wc * 32 + 8 * fq;
        const float wa = ld_agent_f(WSC + GA0 / 32 + 4 * t + wc) * -LOG2E, wb = ld_agent_f(WSC + GB0 / 32 + 4 * t + wc) * -LOG2E;
#pragma unroll
        for (int ai = 0; ai < 2; ++ai)
#pragma unroll
            for (int m = 0; m < 4; ++m) { const int row = u.pm * 256 + ai * 128 + wr * 64 + m * 16 + fr;
                const float xr = ld_agent_f(XS + row), sa_ = xr * wa, sb_ = xr * wb;
                float rr[8], sbv[8];
#pragma unroll
                for (int n = 0; n < 2; ++n) { const i32x4 ia = __builtin_bit_cast(i32x4, acc[ai][0][m][n]), ib = __builtin_bit_cast(i32x4, acc[ai][1][m][n]);
#pragma unroll
                    for (int i = 0; i < 4; ++i) { const float ea = 1.0f + __builtin_amdgcn_exp2f((float)ia[i] * sa_), eb = 1.0f + __builtin_amdgcn_exp2f((float)ib[i] * sb_);
                        rr[4 * n + i] = eb * __builtin_amdgcn_rcpf(ea); sbv[4 * n + i] = __builtin_amdgcn_rcpf(eb); } }
                u32x4 wr_, ws_; wr_.x = pk2(rr[0], rr[1]); wr_.y = pk2(rr[2], rr[3]); wr_.z = pk2(rr[4], rr[5]); wr_.w = pk2(rr[6], rr[7]);
                ws_.x = pk2(sbv[0], sbv[1]); ws_.y = pk2(sbv[2], sbv[3]); ws_.z = pk2(sbv[4], sbv[5]); ws_.w = pk2(sbv[6], sbv[7]);
                *(GAS u32x4*)(P + (size_t)row * INC + GA0 + mcol) = wr_; *(GAS u32x4*)(P + (size_t)row * INC + GB0 + mcol) = ws_; }
        return false;
    }
};
struct EpiProj {
    bf16_t* P; float* KS; const float *qn_a, *kn_a, *qn_b, *kn_b; const float* XS; const float* WSC;
    __device__ __forceinline__ bool operator()(f32x4 (&acc)[2][2][4][2], const g8::Unit& u, int wr, int wc, int fr, int fq) const {
        const int pn = u.pn;
        int kind; const float* gain = nullptr;
        if (pn < 4) { kind = 2; gain = qn_a; } else if (pn == 4) { if (wc < 2) { kind = 1; gain = kn_a; } else kind = 0; }
        else if (pn < 9) { kind = 2; gain = qn_b; } else if (pn < 13) { kind = 3; gain = kn_b; } else kind = 0;
        const int colbase = pn * 256 + wc * 64 + 8 * fq;
        { const float w0 = ld_agent_f(WSC + pn * 8 + wc * 2), w1 = ld_agent_f(WSC + pn * 8 + wc * 2 + 1);
#pragma unroll
          for (int ai = 0; ai < 2; ++ai)
#pragma unroll
              for (int m = 0; m < 4; ++m) { const float xr = ld_agent_f(XS + u.pm * 256 + ai * 128 + wr * 64 + m * 16 + fr);
#pragma unroll
                  for (int bj = 0; bj < 2; ++bj) { const float sc = xr * (bj ? w1 : w0);
#pragma unroll
                      for (int n = 0; n < 2; ++n) { const i32x4 iv = __builtin_bit_cast(i32x4, acc[ai][bj][m][n]); acc[ai][bj][m][n] = (f32x4){(float)iv[0] * sc, (float)iv[1] * sc, (float)iv[2] * sc, (float)iv[3] * sc}; } } } }
        f32x4 gv[2][2];
        if (kind != 0) {
#pragma unroll
            for (int bj = 0; bj < 2; ++bj)
#pragma unroll
                for (int n = 0; n < 2; ++n) gv[bj][n] = *(const GAS f32x4*)(gain + 32 * bj + 8 * fq + 4 * n);
            if (kind == 2) {
#pragma unroll
                for (int bj = 0; bj < 2; ++bj)
#pragma unroll
                    for (int n = 0; n < 2; ++n) gv[bj][n] = gv[bj][n] * QSCALE;
            }
        }
        f32x4 ks[2][2];
#pragma unroll
        for (int bj = 0; bj < 2; ++bj)
#pragma unroll
            for (int n = 0; n < 2; ++n) ks[bj][n] = (f32x4){0.f, 0.f, 0.f, 0.f};
#pragma unroll
        for (int ai = 0; ai < 2; ++ai)
#pragma unroll
            for (int m = 0; m < 4; ++m) { const int row = u.pm * 256 + ai * 128 + wr * 64 + m * 16 + fr;
                if (kind != 0) {
                    float s = 0.f;
#pragma unroll
                    for (int bj = 0; bj < 2; ++bj)
#pragma unroll
                        for (int n = 0; n < 2; ++n) { const f32x4 v = acc[ai][bj][m][n]; s += (v[0] * v[0] + v[1] * v[1]) + (v[2] * v[2] + v[3] * v[3]); }
                    s += __shfl_xor(s, 16); s += __shfl_xor(s, 32);
                    const float rstd = 1.0f / sqrtf(s * (1.f / 64.f) + EPS);
#pragma unroll
                    for (int bj = 0; bj < 2; ++bj)
#pragma unroll
                        for (int n = 0; n < 2; ++n) { acc[ai][bj][m][n] = acc[ai][bj][m][n] * rstd * gv[bj][n]; if (kind == 3) ks[bj][n] += acc[ai][bj][m][n]; }
                }
#pragma unroll
                for (int bj = 0; bj < 2; ++bj) { u32x4 w; const f32x4 a = acc[ai][bj][m][0], b = acc[ai][bj][m][1];
                    w.x = pk2(a[0], a[1]); w.y = pk2(a[2], a[3]); w.z = pk2(b[0], b[1]); w.w = pk2(b[2], b[3]);
                    *(GAS u32x4*)(P + (size_t)row * INC + colbase + 32 * bj) = w; } }
        if (kind == 3) {
            const int bb = u.pm >> 3, blk = u.pm & 7, h = (pn - 9) * 4 + wc;
            float* dst = KS + ((size_t)((bb * 16 + h) * 8 + blk)) * 64 + 8 * fq;
#pragma unroll
            for (int bj = 0; bj < 2; ++bj)
#pragma unroll
                for (int n = 0; n < 2; ++n)
#pragma unroll
                    for (int i = 0; i < 4; ++i) { float v = ks[bj][n][i]; v += __shfl_xor(v, 1); v += __shfl_xor(v, 2); v += __shfl_xor(v, 4); v += __shfl_xor(v, 8);
                        if (fr == 0) atomicAdd(dst + 32 * bj + 4 * n + i, v); }
        }
        return false;
    }
};

struct EpiIn8 { EpiProj p; EpiGate8 g;
    __device__ __forceinline__ bool operator()(f32x4 (&acc)[2][2][4][2], const g8::Unit& u, int wr, int wc, int fr, int fq) const { return (u.pn >= NT_QKV) ? g(acc, u, wr, wc, fr, fq) : p(acc, u, wr, wc, fr, fq); }
};

__device__ __forceinline__ void load_q64(float (&q)[64], const bf16_t* p) {
#pragma unroll
    for (int c = 0; c < 8; ++c) { const u32x4 w = *(const GAS u32x4*)(p + 8 * c);
        q[8 * c + 0] = bf_lo(w.x); q[8 * c + 1] = bf_hi(w.x); q[8 * c + 2] = bf_lo(w.y); q[8 * c + 3] = bf_hi(w.y);
        q[8 * c + 4] = bf_lo(w.z); q[8 * c + 5] = bf_hi(w.z); q[8 * c + 6] = bf_lo(w.w); q[8 * c + 7] = bf_hi(w.w); }
}
__device__ __forceinline__ float dot_q64(const float (&q)[64], const bf16_t* p) {
    float s0 = 0.f, s1 = 0.f;
#pragma unroll
    for (int c = 0; c < 8; ++c) { const u32x4 w = *(const GAS u32x4*)(p + 8 * c);
        s0 += q[8 * c + 0] * bf_lo(w.x); s1 += q[8 * c + 1] * bf_hi(w.x); s0 += q[8 * c + 2] * bf_lo(w.y); s1 += q[8 * c + 3] * bf_hi(w.y);
        s0 += q[8 * c + 4] * bf_lo(w.z); s1 += q[8 * c + 5] * bf_hi(w.z); s0 += q[8 * c + 6] * bf_lo(w.w); s1 += q[8 * c + 7] * bf_hi(w.w); }
    return s0 + s1;
}
__device__ __forceinline__ void attn_naive(const Frame& F) {
    const bf16_t* P = (const bf16_t*)(F.ws + WS_PROJ); const float* KS = (const float*)(F.ws + WS_KSUM);
    bf16_t* OA = (bf16_t*)(F.ws + WS_XN); bf16_t* OB = OA + (size_t)NTOK * 1024;
    LAS float* pbuf = (LAS float*)(F.lds + F.wave * 4096);
    const int gw = F.vcu * NWAVES + F.wave, NGW = F.G * NWAVES, lane = F.lane;
    const int NTASK = 2 * NB * 16 * SEQ;
    for (int k = 0; k * NGW < NTASK; ++k) {
        const int base = k * NGW; const int idx = base + ((gw + 37 * k) % NGW);
        if (idx >= NTASK) continue;
        const int which = idx / (NB * 16 * SEQ); const int r = idx % (NB * 16 * SEQ);
        const int b = r / (16 * SEQ), h = (r / SEQ) % 16, s = r % SEQ;
        const size_t row = (size_t)b * SEQ + s;
        const float slope = __builtin_amdgcn_exp2f(-0.5f * (float)(h + 1)) * LOG2E;
        float q[64];
        if (which == 0) {
            const int kv = h >> 3;
            load_q64(q, P + row * INC + QA0 + h * 64);
            float lsum = 0.f;
#pragma unroll
            for (int c = 0; c < 2; ++c) { const int kpos = s - 127 + lane + 64 * c; float p = 0.f;
                if (kpos >= 0) { const float sc = dot_q64(q, P + ((size_t)b * SEQ + kpos) * INC + KA0 + kv * 64) - slope * (float)(s - kpos); p = __builtin_amdgcn_exp2f(sc); }
                pbuf[64 * c + lane] = p; lsum += p; }
            lsum = wave_sum(lsum) + __builtin_amdgcn_exp2f(F.sinks[h] * LOG2E);
            LDS_WAIT(); asm volatile("" ::: "memory");
            float o = 0.f;
            for (int j = 0; j < 128; ++j) { const int kpos = s - 127 + j; if (kpos < 0) continue;
                const float v = bf_lo((unsigned)P[((size_t)b * SEQ + kpos) * INC + VA0 + kv * 64 + lane]); o += pbuf[j] * v; }
            OA[row * 1024 + h * 64 + lane] = (bf16_t)f2bf(o / lsum);
            LDS_WAIT(); asm volatile("" ::: "memory");
        } else {
            const int t = s >> 8;
            load_q64(q, P + row * INC + QB0 + h * 64);
            float g = -INFINITY;
            if (lane < t) { const float* kr = KS + ((size_t)((b * 16 + h) * 8 + lane)) * 64; float a = 0.f;
#pragma unroll
                for (int d = 0; d < 64; ++d) a += q[d] * ld_agent_f(kr + d);
                g = a; }
            unsigned selmask;
            if (t <= 3) selmask = (1u << t) - 1u;
            else { int rank = 0;
#pragma unroll
                for (int i = 0; i < 7; ++i) { const float gi = __shfl(g, i); if (i < t && (gi > g || (gi == g && i < lane))) ++rank; }
                selmask = (unsigned)__ballot(lane < t && rank < 3); }
            float lsum = 0.f; int nslot = 0; int blk_of[4] = {0, 0, 0, 0};
            for (int j = 0; j <= t; ++j) {
                if (j < t && !((selmask >> j) & 1u)) continue;
#pragma unroll
                for (int c = 0; c < 4; ++c) { const int kpos = 256 * j + 64 * c + lane; float p = 0.f;
                    if (kpos <= s) { const float sc = dot_q64(q, P + ((size_t)b * SEQ + kpos) * INC + KB0 + h * 64) - slope * (float)(s - kpos); p = __builtin_amdgcn_exp2f(sc); }
                    pbuf[nslot * 256 + 64 * c + lane] = p; lsum += p; }
                if (nslot == 0) blk_of[0] = j; else if (nslot == 1) blk_of[1] = j; else if (nslot == 2) blk_of[2] = j; else blk_of[3] = j;
                ++nslot;
            }
            lsum = wave_sum(lsum);
            LDS_WAIT(); asm volatile("" ::: "memory");
            float o = 0.f;
            for (int sl = 0; sl < nslot; ++sl) { const int j = sl == 0 ? blk_of[0] : sl == 1 ? blk_of[1] : sl == 2 ? blk_of[2] : blk_of[3];
                for (int kk = 0; kk < 256; ++kk) { const int kpos = 256 * j + kk; if (kpos > s) break;
                    const float v = bf_lo((unsigned)P[((size_t)b * SEQ + kpos) * INC + VB0 + h * 64 + lane]); o += pbuf[sl * 256 + kk] * v; } }
            OB[row * 1024 + h * 64 + lane] = (bf16_t)f2bf(o / lsum);
            LDS_WAIT(); asm volatile("" ::: "memory");
        }
    }
}

namespace att {
typedef float f32x16 __attribute__((ext_vector_type(16)));
typedef short s16x4 __attribute__((ext_vector_type(4)));
typedef __bf16 bf16x2_t __attribute__((ext_vector_type(2)));
__device__ __forceinline__ unsigned cvtpk(float lo, float hi) { f32x2 v = {lo, hi}; bf16x2_t b = __builtin_convertvector(v, bf16x2_t); return __builtin_bit_cast(unsigned, b); }
__device__ __forceinline__ s16x4 vtr(const LAS char* p) { return __builtin_bit_cast(s16x4, __builtin_amdgcn_ds_read_tr16_b64_v4i16((LAS s16x4*)p)); }
__device__ __forceinline__ void tile_map(int wave, int lane, int& key, int& chunk) { chunk = lane & 7; key = 8 * wave + (((lane >> 3) + (lane & 7)) & 7); }
__device__ __forceinline__ int k_off(int key, int chunk) { return chunk * 1024 + key * 16; }
__device__ __forceinline__ int v_off(int key, int chunk) { return ((chunk >> 2) * 4 + (key >> 4)) * 1024 + (key & 15) * 64 + (chunk & 3) * 16; }

__device__ __forceinline__ void tile_qk(f32x16& p0, f32x16& p1, const LAS char* Kt, const bf16x8 (&qr)[4], float base_l, float ch, int lane) {
    const int r32 = lane & 31, hi = lane >> 5;
#pragma unroll
    for (int r = 0; r < 16; ++r) { p0[r] = base_l + ch * (float)((r & 3) + 8 * (r >> 2)); p1[r] = p0[r] + 32.f * ch; }
    const LAS char* kp = Kt + hi * 1024 + r32 * 16;
    bf16x8 kf[8];
#pragma unroll
    for (int d0 = 0; d0 < 4; ++d0) { kf[2 * d0] = *(const LAS bf16x8*)(kp + d0 * 2048); kf[2 * d0 + 1] = *(const LAS bf16x8*)(kp + d0 * 2048 + 512); }
    __builtin_amdgcn_s_setprio(1);
#pragma unroll
    for (int d0 = 0; d0 < 4; ++d0) {
        p0 = __builtin_amdgcn_mfma_f32_32x32x16_bf16(kf[2 * d0], qr[d0], p0, 0, 0, 0);
        p1 = __builtin_amdgcn_mfma_f32_32x32x16_bf16(kf[2 * d0 + 1], qr[d0], p1, 0, 0, 0);
    }
    __builtin_amdgcn_s_setprio(0);
}
template <int MODE>
__device__ __forceinline__ void tile_sm(f32x16& p0, f32x16& p1, u32x4 (&pw)[4], float& lsum, int qrel, int lane) {
    const int hi = lane >> 5;
    if (MODE != 0) {
#pragma unroll
        for (int r = 0; r < 16; ++r) { const int kk = (r & 3) + 8 * (r >> 2) + 4 * hi; const int d0_ = qrel - kk, d1_ = d0_ - 32;
            const bool ok0 = MODE == 1 ? (d0_ >= 0) : (d0_ >= 0 && d0_ < 128), ok1 = MODE == 1 ? (d1_ >= 0) : (d1_ >= 0 && d1_ < 128);
            p0[r] = ok0 ? p0[r] : -INFINITY; p1[r] = ok1 ? p1[r] : -INFINITY; }
    }
    float s = 0.f;
#pragma unroll
    for (int r = 0; r < 16; ++r) { p0[r] = __builtin_amdgcn_exp2f(p0[r]); p1[r] = __builtin_amdgcn_exp2f(p1[r]); s += p0[r] + p1[r]; }
    lsum += s;
#pragma unroll
    for (int i = 0; i < 4; ++i) { pw[0][i] = cvtpk(p0[2 * i], p0[2 * i + 1]); pw[1][i] = cvtpk(p0[8 + 2 * i], p0[8 + 2 * i + 1]); pw[2][i] = cvtpk(p1[2 * i], p1[2 * i + 1]); pw[3][i] = cvtpk(p1[8 + 2 * i], p1[8 + 2 * i + 1]); }
}
__device__ __forceinline__ void tile_pv(f32x16 (&ot)[2], const LAS char* Vt, const u32x4 (&pw)[4], int lane) {
    const int hi = lane >> 5;
    const LAS char* vp = Vt + ((lane >> 4) & 1) * 32 + (lane & 3) * 8 + (4 * hi + ((lane & 15) >> 2)) * 64;
#pragma unroll
    for (int dh = 0; dh < 2; ++dh) {
        bf16x8 vf[4];
#pragma unroll
        for (int ks = 0; ks < 4; ++ks) { const s16x4 lo = vtr(vp + dh * 4096 + ks * 1024), hh = vtr(vp + dh * 4096 + ks * 1024 + 512);
            vf[ks] = (bf16x8){lo[0], lo[1], lo[2], lo[3], hh[0], hh[1], hh[2], hh[3]}; }
        __builtin_amdgcn_s_setprio(1);
#pragma unroll
        for (int ks = 0; ks < 4; ++ks) ot[dh] = __builtin_amdgcn_mfma_f32_32x32x16_bf16(vf[ks], __builtin_bit_cast(bf16x8, pw[ks]), ot[dh], 0, 0, 0);
        __builtin_amdgcn_s_setprio(0);
    }
}
template <int MODE>
__device__ __forceinline__ void tile_step(const LAS char* Kt, const LAS char* Vt, const bf16x8 (&qr)[4], f32x16 (&ot)[2], float& lsum, float base_l, float ch, int qrel, int lane) {
    f32x16 p0, p1; u32x4 pw[4];
    tile_qk(p0, p1, Kt, qr, base_l, ch, lane);
    tile_sm<MODE>(p0, p1, pw, lsum, qrel, lane);
    tile_pv(ot, Vt, pw, lane);
}
__device__ __forceinline__ void store_o(bf16_t* orow, const f32x16 (&ot)[2], float inv, int hi) {
#pragma unroll
    for (int dh = 0; dh < 2; ++dh)
#pragma unroll
        for (int g = 0; g < 4; ++g) { u32x2 w; w.x = pk2(ot[dh][4 * g] * inv, ot[dh][4 * g + 1] * inv); w.y = pk2(ot[dh][4 * g + 2] * inv, ot[dh][4 * g + 3] * inv);
            *(GAS u32x2*)(orow + 32 * dh + 8 * g + 4 * hi) = w; }
}
__device__ __forceinline__ void load_q(bf16x8 (&qr)[4], const bf16_t* qrow, int hi) {
#pragma unroll
    for (int d0 = 0; d0 < 4; ++d0) qr[d0] = *(const GAS bf16x8*)(qrow + 16 * d0 + 8 * hi);
}

__device__ __forceinline__ void swa_unit(const Frame& F, LAS char* L, int b, int n, int kv, int gh) {
    const bf16_t* P = (const bf16_t*)(F.ws + WS_PROJ); bf16_t* OA = (bf16_t*)(F.ws + WS_XN);
    const int lane = F.lane, w = F.wave, r32 = lane & 31, hi = lane >> 5;
    int key, chunk; tile_map(w, lane, key, chunk);
    const int wb = 128 * n - 128;
    u32x4 kr[4], vr[4];
#pragma unroll
    for (int i = 0; i < 4; ++i) if (n > 0 || i >= 2) { const bf16_t* src = P + ((size_t)b * SEQ + wb + 64 * i + key) * INC + kv * 64 + chunk * 8;
        kr[i] = *(const GAS u32x4*)(src + KA0); vr[i] = *(const GAS u32x4*)(src + VA0); }
#pragma unroll
    for (int i = 0; i < 4; ++i) if (n > 0 || i >= 2) { *(LAS u32x4*)(L + i * 8192 + k_off(key, chunk)) = kr[i]; *(LAS u32x4*)(L + 32768 + i * 8192 + v_off(key, chunk)) = vr[i]; }
    LDS_WAIT(); __syncthreads();
    const int hq = kv * 8 + gh * 4 + (w >> 1);
    const float ch = __builtin_amdgcn_exp2f(-0.5f * (float)(hq + 1)) * LOG2E;
    const float sink = __builtin_amdgcn_exp2f(F.sinks[hq] * LOG2E);
#pragma unroll 1
    for (int sub = 0; sub < 2; ++sub) {
        const int q0w = 64 * (w & 1) + 32 * sub, qw = 128 + q0w + r32;
        const size_t row = (size_t)b * SEQ + 128 * n + q0w + r32;
        bf16x8 qr[4]; load_q(qr, P + row * INC + QA0 + hq * 64, hi);
        f32x16 ot[2]; float lsum = 0.f;
#pragma unroll
        for (int r = 0; r < 16; ++r) { ot[0][r] = 0.f; ot[1][r] = 0.f; }
        const int i0 = q0w >> 6;
#pragma unroll 1
        for (int i = i0; i < i0 + 3; ++i) { if (n == 0 && i < 2) continue;
            tile_step<2>(L + i * 8192, L + 32768 + i * 8192, qr, ot, lsum, ch * (float)(64 * i - qw + 4 * hi), ch, qw - 64 * i, lane); }
        lsum += __shfl_xor(lsum, 32); lsum += sink;
        store_o(OA + row * 1024 + hq * 64, ot, 1.0f / lsum, hi);
    }
    __syncthreads();
}
__device__ __forceinline__ void moba_unit(const Frame& F, LAS char* L, int b, int h, int t) {
    const bf16_t* P = (const bf16_t*)(F.ws + WS_PROJ); const float* KS = (const float*)(F.ws + WS_KSUM); bf16_t* OB = (bf16_t*)(F.ws + WS_XN) + (size_t)NTOK * 1024;
    const int lane = F.lane, w = F.wave, r32 = lane & 31, hi = lane >> 5;
    int key, chunk; tile_map(w, lane, key, chunk);
    const int qpos = 256 * t + 32 * w + r32;
    const size_t row = (size_t)b * SEQ + qpos;
    bf16x8 qr[4]; load_q(qr, P + row * INC + QB0 + h * 64, hi);
    const float ch = __builtin_amdgcn_exp2f(-0.5f * (float)(h + 1)) * LOG2E;
    unsigned selmask = (1u << t) - 1u;
    if (t > 3) {
        float g[7];
#pragma unroll
        for (int j = 0; j < 7; ++j) { float a = 0.f;
            if (j < t) { const float* kr = KS + ((size_t)((b * 16 + h) * 8 + j)) * 64 + 8 * hi;
#pragma unroll
                for (int d0 = 0; d0 < 4; ++d0) { const f32x4 k0 = *(const GAS f32x4*)(kr + 16 * d0), k1 = *(const GAS f32x4*)(kr + 16 * d0 + 4); const u32x4 qw = __builtin_bit_cast(u32x4, qr[d0]);
                    a += bf_lo(qw.x) * k0[0] + bf_hi(qw.x) * k0[1] + bf_lo(qw.y) * k0[2] + bf_hi(qw.y) * k0[3] + bf_lo(qw.z) * k1[0] + bf_hi(qw.z) * k1[1] + bf_lo(qw.w) * k1[2] + bf_hi(qw.w) * k1[3]; }
                a += __shfl_xor(a, 32); }
            g[j] = (j < t) ? a : -INFINITY; }
        selmask = 0u;
#pragma unroll
        for (int j = 0; j < 7; ++j) { int rank = 0;
#pragma unroll
            for (int i = 0; i < 7; ++i) if (i != j) rank += (g[i] > g[j] || (g[i] == g[j] && i < j)) ? 1 : 0;
            if (j < t && rank < 3) selmask |= 1u << j; }
    }
    f32x16 ot[2]; float lsum = 0.f;
#pragma unroll
    for (int r = 0; r < 16; ++r) { ot[0][r] = 0.f; ot[1][r] = 0.f; }
    const int NS = 2 * (t + 1);
    const bf16_t* src0 = P + ((size_t)b * SEQ + key) * INC + h * 64 + chunk * 8;
    const int ko = k_off(key, chunk), vo = v_off(key, chunk);
#define MOBA_LOAD(R, step) do { const bf16_t* _s = src0 + (size_t)(128 * (step)) * INC; R[0] = *(const GAS u32x4*)(_s + KB0); R[1] = *(const GAS u32x4*)(_s + (size_t)64 * INC + KB0); \
        R[2] = *(const GAS u32x4*)(_s + VB0); R[3] = *(const GAS u32x4*)(_s + (size_t)64 * INC + VB0); } while (0)
#define MOBA_STEP(R, it) do { LAS char* B0 = L + ((it) & 1) * 32768; \
        *(LAS u32x4*)(B0 + ko) = R[0]; *(LAS u32x4*)(B0 + 8192 + ko) = R[1]; *(LAS u32x4*)(B0 + 16384 + vo) = R[2]; *(LAS u32x4*)(B0 + 24576 + vo) = R[3]; \
        LDS_WAIT(); asm volatile("" ::: "memory"); __builtin_amdgcn_s_barrier(); asm volatile("" ::: "memory");     \
        if ((it) + 2 < NS) MOBA_LOAD(R, (it) + 2); \
        const int j = (it) >> 1, tb = 128 * (it); \
        const bool past = j < t; const bool sel = past ? ((selmask >> j) & 1u) != 0u : true; \
        const int dg = past ? 99 : (w >> 1); \
        _Pragma("unroll 1") for (int c = 0; c < 2; ++c) { \
            const int tc = ((it) & 1) * 2 + c, tbc = tb + 64 * c; \
            const float bl = sel ? ch * (float)(tbc - qpos + 4 * hi) : -1e30f; \
            if (tc < dg) tile_step<0>(B0 + c * 8192, B0 + 16384 + c * 8192, qr, ot, lsum, bl, ch, 0, lane); \
            else if (tc == dg) tile_step<1>(B0 + c * 8192, B0 + 16384 + c * 8192, qr, ot, lsum, bl, ch, qpos - tbc, lane); } } while (0)
    u32x4 Ra[4], Rb[4];
    MOBA_LOAD(Ra, 0); MOBA_LOAD(Rb, 1);
#pragma unroll 1
    for (int it = 0; it < NS; it += 2) { MOBA_STEP(Ra, it); MOBA_STEP(Rb, it + 1); }
#undef MOBA_LOAD
#undef MOBA_STEP
    lsum += __shfl_xor(lsum, 32);
    store_o(OB + row * 1024 + h * 64, ot, 1.0f / lsum, hi);
    __syncthreads();
}
__device__ __forceinline__ void attn_phase(const Frame& F) {
    LAS char* L = (LAS char*)F.lds;
    { const int v = F.vcu; swa_unit(F, L, v >> 6, (v >> 2) & 15, (v >> 1) & 1, v & 1); }
    { const int bh = F.vcu >> 2, pr = F.vcu & 3; moba_unit(F, L, bh >> 4, bh & 15, 7 - pr); moba_unit(F, L, bh >> 4, bh & 15, pr); }
}
}

struct SchedUp {
    const char* A; const char* Bt; int G, c;
    __device__ __forceinline__ bool next(int i, g8::Unit& u) const {
        if (i >= 2) return false; int pm, pn; if (!g8::tile_order(32, 8, G, c, 0, pm, pn)) return false;
        u.a = A + ((size_t)i * NTOK + (size_t)pm * 256) * 1024 * 2; u.b = Bt + ((size_t)i * DM + (size_t)pn * 256) * 1024 * 2; u.rows = nullptr; u.nkt = 16; u.pm = pm; u.pn = pn; u.x0 = i; u.x1 = 0; return true;
    }
};
struct EpiUp {
    const bf16_t* P; bf16_t* MG;
    __device__ __forceinline__ bool operator()(f32x4 (&acc)[2][2][4][2], const g8::Unit& u, int wr, int wc, int fr, int fq) const {
        const int col = u.pn * 256 + wc * 64 + 8 * fq; const int gofs = (u.x0 == 0) ? GA0 : GB0;
#pragma unroll
        for (int ai = 0; ai < 2; ++ai) {
            u32x4 gv[4][2];
#pragma unroll
            for (int m = 0; m < 4; ++m)
#pragma unroll
                for (int bj = 0; bj < 2; ++bj) gv[m][bj] = *(const GAS u32x4*)(P + (size_t)(u.pm * 256 + ai * 128 + wr * 64 + m * 16 + fr) * INC + gofs + col + 32 * bj);
#pragma unroll
            for (int m = 0; m < 4; ++m) { const int row = u.pm * 256 + ai * 128 + wr * 64 + m * 16 + fr;
#pragma unroll
                for (int bj = 0; bj < 2; ++bj) {
                    const u32x4 g = gv[m][bj];
                    const float b0 = bf_lo(g.x), b1 = bf_hi(g.x), b2 = bf_lo(g.y), b3 = bf_hi(g.y), b4 = bf_lo(g.z), b5 = bf_hi(g.z), b6 = bf_lo(g.w), b7 = bf_hi(g.w);
                    f32x4& v0 = acc[ai][bj][m][0]; f32x4& v1 = acc[ai][bj][m][1];
                    if (u.x0 == 0) {
                        v0[0] *= b0; v0[1] *= b1; v0[2] *= b2; v0[3] *= b3; v1[0] *= b4; v1[1] *= b5; v1[2] *= b6; v1[3] *= b7;
                    } else {
                        u32x4 w; w.x = pk2(v0[0] * b0, v0[1] * b1); w.y = pk2(v0[2] * b2, v0[3] * b3); w.z = pk2(v1[0] * b4, v1[1] * b5); w.w = pk2(v1[2] * b6, v1[3] * b7);
                        *(GAS u32x4*)(MG + (size_t)row * DM + col + 32 * bj) = w;
                    } } }
        }
        return u.x0 == 0;
    }
};

struct EpiOut {
    const float* X; bf16_t* X1B; float* SS; unsigned char* X8;
    __device__ __forceinline__ bool operator()(f32x4 (&acc)[2][2][4][2], const g8::Unit& u, int wr, int wc, int fr, int fq) const {
        const int col = u.pn * 256 + wc * 64 + 8 * fq;
#pragma unroll
        for (int ai = 0; ai < 2; ++ai) {
            f32x4 xa[4][2], xb[4][2];
#pragma unroll
            for (int m = 0; m < 4; ++m)
#pragma unroll
                for (int bj = 0; bj < 2; ++bj) { const size_t off = (size_t)(u.pm * 256 + ai * 128 + wr * 64 + m * 16 + fr) * DM + col + 32 * bj; xa[m][bj] = NT_LD4(X + off); xb[m][bj] = NT_LD4(X + off + 4); }
#pragma unroll
            for (int m = 0; m < 4; ++m) { const int row = u.pm * 256 + ai * 128 + wr * 64 + m * 16 + fr; float s = 0.f;
#pragma unroll
                for (int bj = 0; bj < 2; ++bj) { const size_t off = (size_t)row * DM + col + 32 * bj;
                    const f32x4 a = xa[m][bj] + acc[ai][bj][m][0], b = xb[m][bj] + acc[ai][bj][m][1];
                    s += (a[0] * a[0] + a[1] * a[1]) + (a[2] * a[2] + a[3] * a[3]) + (b[0] * b[0] + b[1] * b[1]) + (b[2] * b[2] + b[3] * b[3]);
                    u32x4 w; w.x = pk2(a[0], a[1]); w.y = pk2(a[2], a[3]); w.z = pk2(b[0], b[1]); w.w = pk2(b[2], b[3]);
                    *(GAS u32x4*)(X1B + off) = w;
                    u32x2 w8; w8.x = pk8(a[0] * SX8, a[1] * SX8, a[2] * SX8, a[3] * SX8); w8.y = pk8(b[0] * SX8, b[1] * SX8, b[2] * SX8, b[3] * SX8); *(GAS u32x2*)(X8 + off) = w8; }
                s += __shfl_xor(s, 16); s += __shfl_xor(s, 32);
                if (fq == 0) SS[(size_t)row * 32 + u.pn * 4 + wc] = s; }
        }
        return false;
    }
};

__device__ __forceinline__ void p5a_route(const Frame& F) {
    typedef float f32x16 __attribute__((ext_vector_type(16)));
    const bf16_t* X1B = (const bf16_t*)(F.ws + WS_XN); const float* SS = (const float*)(F.ws + WS_SS); const bf16_t* GWT = (const bf16_t*)(F.ws + WS_GWT);
    unsigned* TOS = (unsigned*)(F.ws + WS_SL + SL_TOS); float* WOS = (float*)(F.ws + WS_SL + SL_WOS); float* RSOS = (float*)(F.ws + WS_SL + SL_RSOS);
    unsigned* ECNT = (unsigned*)(F.ws + WS_CTL) + CW_ECNT; unsigned* BCNT = (unsigned*)(F.ws + WS_CTL) + CW_BCNT;
    unsigned* BTOK = (unsigned*)(F.ws + WS_BK + BK_TOK); unsigned* BRA = (unsigned*)(F.ws + WS_BK + BK_RA); unsigned* BRB = (unsigned*)(F.ws + WS_BK + BK_RB);
    LAS unsigned* le = (LAS unsigned*)(F.lds + LDS_X_OFF);
    LAS float* lw = (LAS float*)(le + 64); LAS float* lr = lw + 64; LAS unsigned* lb = (LAS unsigned*)(lr + 32);
    LAS unsigned* lk = lb + 16; LAS unsigned* lkb = lk + 32; LAS unsigned* lsl = lkb + 32;
    LAS float* PT = (LAS float*)F.lds;
    const int lane = F.lane, w = F.wave, r32 = lane & 31, hi = lane >> 5, tokb = F.vcu * 32;
    f32x16 acc;
#pragma unroll
    for (int r = 0; r < 16; ++r) acc[r] = 0.f;
    const bf16_t* xa = X1B + (size_t)(tokb + r32) * DM + 256 * w + 8 * hi; const bf16_t* gb = GWT + (size_t)r32 * DM + 256 * w + 8 * hi;
#pragma unroll 1
    for (int hb = 0; hb < 2; ++hb) {
        bf16x8 af[8], bfr[8];
#pragma unroll
        for (int i = 0; i < 8; ++i) { af[i] = *(const GAS bf16x8*)(xa + 128 * hb + 16 * i); bfr[i] = *(const GAS bf16x8*)(gb + 128 * hb + 16 * i); }
#pragma unroll
        for (int i = 0; i < 8; ++i) acc = __builtin_amdgcn_mfma_f32_32x32x16_bf16(af[i], bfr[i], acc, 0, 0, 0);
    }
#pragma unroll
    for (int r = 0; r < 16; ++r) PT[(w * 32 + ((r & 3) + 8 * (r >> 2) + 4 * hi)) * 32 + r32] = acc[r];
    LDS_WAIT(); __syncthreads();
    LAS float* LG = PT + 8192;
#pragma unroll
    for (int i = 0; i < 2; ++i) { const int o = F.tid + 512 * i; float v = 0.f;
#pragma unroll
        for (int ww = 0; ww < 8; ++ww) v += PT[ww * 1024 + o];
        LG[o] = v; }
    LDS_WAIT(); __syncthreads();
    if (F.tid < 32) {
        const int lt = F.tid, tok = tokb + lt; float ss = 0.f;
#pragma unroll
        for (int j = 0; j < 8; ++j) { const f32x4 p = ((const GAS f32x4*)(SS + (size_t)tok * 32))[j]; ss += (p.x + p.y) + (p.z + p.w); }
        const float rstd = 1.0f / sqrtf(ss * (1.f / DM) + EPS);
        float lgp[4], el[4];
#pragma unroll
        for (int c = 0; c < 4; ++c) lgp[c] = LG[lt * 32 + c] * rstd;
        int gi = 0; float gm = lgp[0];
#pragma unroll
        for (int c = 1; c < 4; ++c) if (lgp[c] > gm) { gm = lgp[c]; gi = c; }
        float gden = 0.f;
#pragma unroll
        for (int c = 0; c < 4; ++c) gden += __expf(lgp[c] - gm);
        const float g_p = 1.0f / gden;
#pragma unroll
        for (int c = 0; c < 4; ++c) el[c] = LG[lt * 32 + 4 + 4 * gi + c] * rstd;
        int e1 = 0; float m1 = el[0];
#pragma unroll
        for (int c = 1; c < 4; ++c) if (el[c] > m1) { m1 = el[c]; e1 = c; }
        int e2 = -1; float m2 = -INFINITY;
#pragma unroll
        for (int c = 0; c < 4; ++c) if (c != e1 && el[c] > m2) { m2 = el[c]; e2 = c; }
        const float w1 = g_p / (1.0f + __expf(m2 - m1)), w2 = g_p / (1.0f + __expf(m1 - m2));
        le[2 * lt] = (unsigned)(gi * 4 + e1); le[2 * lt + 1] = (unsigned)(gi * 4 + e2); lw[2 * lt] = w1; lw[2 * lt + 1] = w2; lr[lt] = rstd;
        const int ea = e1 < e2 ? e1 : e2, eb = e1 < e2 ? e2 : e1;
        lk[lt] = (unsigned)(gi * 6 + ((ea * (7 - ea)) >> 1) + (eb - ea - 1)) | (e1 > e2 ? 64u : 0u);
    }
    LDS_WAIT(); __syncthreads();
    if (F.tid < NEXP) { unsigned c = 0; for (int i = 0; i < 64; ++i) c += (le[i] == (unsigned)F.tid) ? 1u : 0u; lb[F.tid] = c ? __hip_atomic_fetch_add(ECNT + F.tid, c, RLX_AGENT) : 0u; }
    else if (F.tid >= 64 && F.tid < 64 + NBK) { const unsigned b = (unsigned)(F.tid - 64); unsigned c = 0; for (int i = 0; i < 32; ++i) c += ((lk[i] & 63u) == b) ? 1u : 0u; lkb[b] = c ? __hip_atomic_fetch_add(BCNT + b, c, RLX_AGENT) : 0u; }
    LDS_WAIT(); __syncthreads();
    if (F.tid < 64) { const int a = F.tid; const unsigned e = le[a]; unsigned rank = 0;
        for (int i = 0; i < a; ++i) rank += (le[i] == e) ? 1u : 0u;
        const unsigned slot = e * ECAP + lb[e] + rank; const int tok = F.vcu * 32 + (a >> 1);
        TOS[slot] = (unsigned)tok; WOS[slot] = lw[a]; RSOS[slot] = lr[a >> 1]; lsl[a] = slot; }
    LDS_WAIT(); __syncthreads();
    if (F.tid < 32) { const int lt = F.tid; const unsigned kk = lk[lt], b = kk & 63u, sw = kk >> 6; unsigned rank = 0;
        for (int i = 0; i < lt; ++i) rank += ((lk[i] & 63u) == b) ? 1u : 0u;
        const unsigned bs = b * BCAP + lkb[b] + rank;
        BTOK[bs] = (unsigned)(tokb + lt); BRA[bs] = lsl[2 * lt + (int)sw]; BRB[bs] = lsl[2 * lt + 1 - (int)sw]; }
    __syncthreads();
}
struct MoeInfo { unsigned mt0[NEXP + 1]; };
__device__ __forceinline__ int moe_expert_of(const LAS unsigned* mt0, int mtile) { int e = 0;
#pragma unroll
    for (int q = 1; q < NEXP; ++q) if ((unsigned)mtile >= mt0[q]) e = q; return e; }
struct SchedMoeUp {
    const char* H2; const char* Wgu; const int* TOS; const LAS unsigned* mt0; int G, c;
    __device__ __forceinline__ bool next(int i, g8::Unit& u) const {
        const int L = i * G + c; const int nun = (int)mt0[NEXP] * 4; if (L >= nun) return false;
        const int mtile = L >> 2, nt = L & 3, e = moe_expert_of(mt0, mtile), sb = e * ECAP + (mtile - (int)mt0[e]) * 256;
        u.a = H2; u.rows = TOS + sb; u.b = Wgu + ((size_t)e * 1024 + (size_t)nt * 256) * DM; u.nkt = DM / 128; u.pm = mtile; u.pn = nt; u.x0 = e; u.x1 = sb; return true;
    }
};
struct EpiMoeUp {
    const float* WOS; const float* RSOS; bf16_t* HID;
    __device__ __forceinline__ bool operator()(f32x4 (&acc)[2][2][4][2], const g8::Unit& u, int wr, int wc, int fr, int fq) const {
        const int col = u.pn * 128 + wc * 32 + 8 * fq;
        float wv[2][4], rv[2][4];
#pragma unroll
        for (int ai = 0; ai < 2; ++ai)
#pragma unroll
            for (int m = 0; m < 4; ++m) { const int slot = u.x1 + ai * 128 + wr * 64 + m * 16 + fr; wv[ai][m] = WOS[slot]; rv[ai][m] = RSOS[slot] * (1.0f / (SX8 * SW8)); }
#pragma unroll
        for (int ai = 0; ai < 2; ++ai)
#pragma unroll
            for (int m = 0; m < 4; ++m) { const int slot = u.x1 + ai * 128 + wr * 64 + m * 16 + fr; const float w = wv[ai][m], rs = rv[ai][m];
                float hv[8];
#pragma unroll
                for (int n = 0; n < 2; ++n)
#pragma unroll
                    for (int i = 0; i < 4; ++i) { const float g = acc[ai][0][m][n][i] * rs, up = acc[ai][1][m][n][i] * rs;
                        hv[4 * n + i] = g * __builtin_amdgcn_rcpf(1.0f + __builtin_amdgcn_exp2f(-g * LOG2E)) * up * w; }
#pragma unroll
                for (int q = 0; q < 8; ++q) hv[q] = fminf(fmaxf(hv[q] * SH8, -448.f), 448.f);
                u32x2 o; o.x = pk8(hv[0], hv[1], hv[2], hv[3]); o.y = pk8(hv[4], hv[5], hv[6], hv[7]);
                *(GAS u32x2*)((unsigned char*)HID + (size_t)slot * DEXP + col) = o; }
        return false;
    }
};
__device__ __forceinline__ int moe_bucket_of(const LAS unsigned* bt0, int mtile) { int b = 0;
#pragma unroll
    for (int q = 1; q < NBK; ++q) if ((unsigned)mtile >= bt0[q]) b = q; return b; }
struct SchedMoeDown {
    const char* HID; const char* Wd; const int* BRA; const int* BRB; const LAS unsigned* bt0; int G, c;
    __device__ __forceinline__ bool next(int i, g8::Unit& u) const {
        const int h = i & 1, L = (i >> 1) * G + c; const int nun = (int)bt0[NBK] * 8; if (L >= nun) return false;
        const int mtile = L >> 3, pn = L & 7, b = moe_bucket_of(bt0, mtile), lt = mtile - (int)bt0[b], sb = b * BCAP + lt * 256;
        const int g = b / 6, p = b - g * 6, e = g * 4 + (int)(((h ? 0xFB9u : 0x940u) >> (2 * p)) & 3u);
        int lim = (int)bt0[64 + b] - lt * 256; lim = lim > 256 ? 256 : lim;
        u.a = HID; u.rows = (h ? BRB : BRA) + sb; u.b = Wd + ((size_t)e * DM + (size_t)pn * 256) * DEXP; u.nkt = DEXP / 128; u.pm = mtile; u.pn = pn; u.x0 = h | (lim << 1); u.x1 = sb; return true;
    }
};
struct EpiMoeDown {
    float* out; const bf16_t* X1B; const unsigned* BTOK;
    __device__ __forceinline__ bool operator()(f32x4 (&acc)[2][2][4][2], const g8::Unit& u, int wr, int wc, int fr, int fq) const {
        if ((u.x0 & 1) == 0) return true;
        const int lim = u.x0 >> 1, col = u.pn * 256 + wc * 64 + 8 * fq; constexpr float isc = 1.0f / (SH8 * SD8);
#pragma unroll
        for (int ai = 0; ai < 2; ++ai) {
            unsigned tk[4]; u32x4 xv[4][2];
#pragma unroll
            for (int m = 0; m < 4; ++m) { const int r = ai * 128 + wr * 64 + m * 16 + fr; tk[m] = BTOK[u.x1 + r]; }
#pragma unroll
            for (int m = 0; m < 4; ++m)
#pragma unroll
                for (int bj = 0; bj < 2; ++bj) xv[m][bj] = *(const GAS u32x4*)(X1B + (size_t)tk[m] * DM + col + 32 * bj);
#pragma unroll
            for (int m = 0; m < 4; ++m) { const int r = ai * 128 + wr * 64 + m * 16 + fr;
                if (r < lim) {
#pragma unroll
                    for (int bj = 0; bj < 2; ++bj) { const u32x4 x = xv[m][bj]; const f32x4 a = acc[ai][bj][m][0], b = acc[ai][bj][m][1];
                        f32x4 o0, o1; o0[0] = bf_lo(x.x) + a[0] * isc; o0[1] = bf_hi(x.x) + a[1] * isc; o0[2] = bf_lo(x.y) + a[2] * isc; o0[3] = bf_hi(x.y) + a[3] * isc;
                        o1[0] = bf_lo(x.z) + b[0] * isc; o1[1] = bf_hi(x.z) + b[1] * isc; o1[2] = bf_lo(x.w) + b[2] * isc; o1[3] = bf_hi(x.w) + b[3] * isc;
                        GAS f32x4* op = (GAS f32x4*)(out + (size_t)tk[m] * DM + col + 32 * bj); __builtin_nontemporal_store(o0, op); __builtin_nontemporal_store(o1, op + 1); } } }
        }
        return false;
    }
};
__device__ __forceinline__ void moe_load_buckets(const Frame& F, LAS unsigned* bt0) {
    const unsigned* BCNT = (const unsigned*)(F.ws + WS_CTL) + CW_BCNT;
    if (F.tid < NBK) { const unsigned c = ld_agent(BCNT + F.tid); bt0[64 + F.tid] = c; bt0[32 + F.tid] = (c + 255u) >> 8; }
    LDS_WAIT(); __syncthreads();
    if (F.tid == 0) { unsigned s = 0; for (int b = 0; b < NBK; ++b) { bt0[b] = s; s += bt0[32 + b]; } bt0[NBK] = s; }
    LDS_WAIT(); __syncthreads();
}
__device__ __forceinline__ void moe_load_info(const Frame& F, LAS unsigned* mt0) {
    const unsigned* ECNT = (const unsigned*)(F.ws + WS_CTL) + CW_ECNT;
    if (F.tid < NEXP) mt0[32 + F.tid] = (ld_agent(ECNT + F.tid) + 255u) >> 8;
    LDS_WAIT(); __syncthreads();
    if (F.tid == 0) { unsigned s = 0; for (int e = 0; e < NEXP; ++e) { mt0[e] = s; s += mt0[32 + e]; } mt0[NEXP] = s; }
    LDS_WAIT(); __syncthreads();
}

constexpr int N_PHASES = 9;
__global__ void __launch_bounds__(NWAVES * 64, 2) fwd(Args args) {
    extern __shared__ __attribute__((aligned(16))) unsigned char lds[];
    Frame F;
    F.lds = (LAS unsigned char*)lds;
    F.tid = threadIdx.x; F.lane = F.tid & 63; F.wave = __builtin_amdgcn_readfirstlane(F.tid >> 6);
    F.G = gridDim.x; { const int bx = blockIdx.x; F.vcu = (F.G % 8 == 0) ? (bx % 8) * (F.G / 8) + bx / 8 : bx; }
    F.x = args.in[0]; F.g_mix = args.in[1]; F.w_in = args.in[2]; F.qn_a = args.in[3]; F.kn_a = args.in[4]; F.sinks = args.in[5]; F.qn_b = args.in[6]; F.kn_b = args.in[7];
    F.w_upa = args.in[8]; F.w_upb = args.in[9]; F.w_out = args.in[10]; F.g_ffn = args.in[11]; F.w_rg = args.in[12]; F.w_re = args.in[13]; F.w_ge = args.in[14]; F.w_ue = args.in[15]; F.w_de = args.in[16];
    F.out = args.out; F.ws = args.ws;
    volatile LAS unsigned* MISC = (volatile LAS unsigned*)(F.lds + MISC_OFF);
    for (int u = F.tid; u < (LDS_X_OFF - LDSCTL_OFF) / 4; u += NWAVES * 64) ((LAS unsigned*)(F.lds + LDSCTL_OFF))[u] = 0u;
    __syncthreads();
    gu32* ctl = (gu32*)(F.ws + WS_CTL);
    XcdBarrier bar; bar.bar = (unsigned*)(ctl + CW_BAR); bar.x = 0; bar.st = nullptr;
    const int lo = args.ph_lo, hi = args.ph_hi;
    const bool multi = (hi - lo) > 1;
    if (multi) bar = xcd_barrier_post((unsigned*)(ctl + CW_BAR), MISC + 8);
#define IN(k) (lo <= (k) && (k) < hi)
#define SEAM(k) do { if (IN(k) && IN((k) + 1)) xcd_barrier(bar); } while (0)
    const int cid = (int)blockIdx.x;

    if (IN(0)) { p0_prologue(F); SEAM(0); }
    if (IN(1)) {
        { SchedIn8 S{(const char*)(F.ws + WS_X8), (const char*)(F.ws + WS_WIN8), F.G, cid};
          const float* XS = (const float*)(F.ws + WS_XS); const float* WSC = (const float*)(F.ws + WS_WSC);
          EpiIn8 E{EpiProj{(bf16_t*)(F.ws + WS_PROJ), (float*)(F.ws + WS_KSUM), F.qn_a, F.kn_a, F.qn_b, F.kn_b, XS, WSC}, EpiGate8{(bf16_t*)(F.ws + WS_PROJ), XS, WSC}};
          g8::gemm_phase<EpiIn8, SchedIn8, false, false, true>(F.lds, DM / 2, DM / 2, S, E); }
        { constexpr int NUN = (NTOK / 256) * (INC / 256); const int r = NUN % F.G;
          if (r == 0) convert_moe_gate_up(F, cid, F.G); else if (cid >= r) convert_moe_gate_up(F, cid - r, F.G - r); }
        SEAM(1);
    }
    #if defined(ATTN_NAIVE)
    if (IN(2)) { attn_naive(F); SEAM(2); }
#else
    if (IN(2)) { att::attn_phase(F); SEAM(2); }
#endif
    if (IN(3)) {
        SchedUp S{(const char*)(F.ws + WS_XN), (const char*)(F.ws + WS_WUP), F.G, cid};
        EpiUp E{(const bf16_t*)(F.ws + WS_PROJ), (bf16_t*)(F.ws + WS_MERGED)};
        g8::gemm_phase<EpiUp, SchedUp, false>(F.lds, 1024, 1024, S, E);
        SEAM(3);
    }
    if (IN(4)) {
        SchedTiles S{(const char*)(F.ws + WS_MERGED), (const char*)(F.ws + WS_WOUT), NTOK / 256, DM / 256, DM, F.G, cid};
        EpiOut E{F.x, (bf16_t*)(F.ws + WS_XN), (float*)(F.ws + WS_SS), (unsigned char*)(F.ws + WS_X8)};
        g8::gemm_phase<EpiOut, SchedTiles, false>(F.lds, DM, DM, S, E);
        SEAM(4);
    }
    if (IN(5)) { p5a_route(F); if (IN(5) && IN(7)) xcd_barrier(bar); }
    LAS unsigned* mt0 = (LAS unsigned*)(F.lds + LDS_X_OFF + 1024);
    if (IN(7)) {
        moe_load_info(F, mt0);
        SchedMoeUp S{(const char*)(F.ws + WS_X8), (const char*)(F.ws + WS_WGU), (const int*)(F.ws + WS_SL + SL_TOS), mt0, F.G, F.vcu};
        EpiMoeUp E{(const float*)(F.ws + WS_SL + SL_WOS), (const float*)(F.ws + WS_SL + SL_RSOS), (bf16_t*)(F.ws + WS_PROJ)};
        g8::gemm_phase<EpiMoeUp, SchedMoeUp, true, true>(F.lds, DM / 2, DM / 2, S, E);
        { const int r = ((int)mt0[NEXP] * 4) % F.G;
          if (r == 0) convert_moe_down(F, F.vcu, F.G); else if (F.vcu >= r) convert_moe_down(F, F.vcu - r, F.G - r); }
        SEAM(7);
    }
    if (IN(8)) {
        LAS unsigned* bt0 = mt0 + 128;
        moe_load_buckets(F, bt0);
        SchedMoeDown S{(const char*)(F.ws + WS_PROJ), (const char*)(F.ws + WS_WD), (const int*)(F.ws + WS_BK + BK_RA), (const int*)(F.ws + WS_BK + BK_RB), bt0, F.G, F.vcu};
        EpiMoeDown E{F.out, (const bf16_t*)(F.ws + WS_XN), (const unsigned*)(F.ws + WS_BK + BK_TOK)};
        g8::gemm_phase<EpiMoeDown, SchedMoeDown, true, true>(F.lds, DEXP / 2, DEXP / 2, S, E);
    }
#undef IN
#undef SEAM
}

extern "C" void kernel_launch(void* const* d_in, const int* in_sizes, int n_in, void* d_out, int out_size, void* d_ws, size_t ws_size, hipStream_t stream) {
    static int grid = 0;
    if (grid == 0) {
        if (n_in != 17 || in_sizes[0] != NTOK * DM || out_size != NTOK * DM || ws_size < WS_END) {
            fprintf(stderr, "kernel_launch: unexpected problem (n_in %d, in0 %d, out %d, ws %zu)\n", n_in, n_in > 0 ? in_sizes[0] : -1, out_size, ws_size); grid = -1; return; }
        int dev = 0, cus = 0, per_cu = 0;
        if (hipGetDevice(&dev) != hipSuccess || hipDeviceGetAttribute(&cus, hipDeviceAttributeMultiprocessorCount, dev) != hipSuccess) { grid = -1; return; }
        if (hipFuncSetAttribute((const void*)fwd, hipFuncAttributeMaxDynamicSharedMemorySize, LDS_BYTES) != hipSuccess) { fprintf(stderr, "kernel_launch: hipFuncSetAttribute failed\n"); grid = -1; return; }
        if (hipOccupancyMaxActiveBlocksPerMultiprocessor(&per_cu, (const void*)fwd, NWAVES * 64, LDS_BYTES) != hipSuccess || per_cu < 1)
            fprintf(stderr, "kernel_launch: occupancy query reports %d workgroups per CU\n", per_cu);
        (void)hipGetLastError();
        grid = cus;
        if (grid != 256) fprintf(stderr, "kernel_launch: %d CUs (built for 256)\n", grid);
    }
    if (grid < 0) return;
    (void)hipMemsetAsync((char*)d_ws + WS_CTL, 0, CTL_ZERO_BYTES, stream);
    Args a{};
    for (int i = 0; i < 17; ++i) a.in[i] = (const float*)d_in[i];
    a.out = (float*)d_out; a.ws = (unsigned char*)d_ws;
#if MK_LAUNCHES == 1
    a.ph_lo = 0; a.ph_hi = N_PHASES;
    hipLaunchKernelGGL(fwd, dim3(grid), dim3(NWAVES * 64), LDS_BYTES, stream, a);
#else
#ifndef PROBE_REP_MASK
#define PROBE_REP_MASK 0
#endif
    for (int p = 0; p < N_PHASES; ++p) { if (p == 6) continue; a.ph_lo = p; a.ph_hi = p + 1;
        for (int rep = 0; rep < 1 + ((PROBE_REP_MASK >> p) & 1); ++rep) hipLaunchKernelGGL(fwd, dim3(grid), dim3(NWAVES * 64), LDS_BYTES, stream, a); }
#endif
}
```

```cpp
#include <hip/hip_runtime.h>
#include <cstdio>
#include <cstdint>

#ifndef MK_LAUNCHES
#define MK_LAUNCHES 1
#endif

#define LAS __attribute__((address_space(3)))
#define GAS __attribute__((address_space(1)))
typedef unsigned short bf16_t;
typedef short bf16x8 __attribute__((ext_vector_type(8)));
typedef float f32x4 __attribute__((ext_vector_type(4)));
typedef float f32x2 __attribute__((ext_vector_type(2)));
typedef unsigned u32x4 __attribute__((ext_vector_type(4)));
typedef unsigned u32x2 __attribute__((ext_vector_type(2)));
typedef GAS unsigned gu32;
#define RLX_AGENT __ATOMIC_RELAXED, __HIP_MEMORY_SCOPE_AGENT

constexpr int DM = 2048, NB = 4, SEQ = 2048, NTOK = NB * SEQ, HD = 64;
constexpr int INC = 8448;
constexpr int QA0 = 0, KA0 = 1024, VA0 = 1152, QB0 = 1280, KB0 = 2304, VB0 = 3328, GA0 = 4352, GB0 = 6400;
constexpr int NEXP = 16, DEXP = 512;
constexpr float EPS = 1e-6f;
constexpr float LOG2E = 1.4426950408889634f;
constexpr float QSCALE = 0.125f * LOG2E;
constexpr int SLOT_CAP = NTOK * 2 + NEXP * 256;

constexpr size_t MiB = 1u << 20;
constexpr size_t WS_CTL = 0, CTL_ZERO_BYTES = 64 * 1024;
constexpr size_t WS_KSUM = 1 * MiB;
constexpr size_t WS_XS = 1 * MiB + 512 * 1024;
constexpr size_t WS_WSC = 1 * MiB + 768 * 1024;
constexpr size_t WS_SS = 2 * MiB;
constexpr size_t WS_RT = 3 * MiB;
constexpr size_t RT_TOKE = 0, RT_TOKW = 64 * 1024, RT_CNT = 128 * 1024, RT_INFO = 160 * 1024, RT_TOS = 192 * 1024, RT_WOS = 320 * 1024, RT_SOT = 448 * 1024, RT_RSTD = 512 * 1024, RT_RSOS = 576 * 1024;
constexpr size_t WS_WIN = 4 * MiB;
constexpr size_t WS_WUP = 37 * MiB;
constexpr size_t WS_WOUT = 45 * MiB;
constexpr size_t WS_WGU = 53 * MiB;
constexpr size_t WS_WD = 117 * MiB;
constexpr size_t WS_XN = 149 * MiB;
constexpr size_t WS_PROJ = 181 * MiB;
constexpr size_t WS_MERGED = 4 * MiB;
constexpr size_t WS_SL = 313 * MiB;
constexpr size_t SL_TOS = 0, SL_WOS = 512 * 1024, SL_RSOS = 1024 * 1024, SL_T2S = 1536 * 1024;
constexpr size_t WS_Y2 = 4 * MiB;
constexpr int NBK = 24, BCAP = 8192;
constexpr int ECAP = 8192;
constexpr size_t WS_GWT = 3 * MiB;
constexpr size_t WS_X8 = 316 * MiB;
constexpr size_t WS_BK = 332 * MiB;
constexpr size_t BK_TOK = 0, BK_RA = 768 * 1024, BK_RB = 1536 * 1024, BK_BYTES = 2304 * 1024;
constexpr size_t WS_END = 335 * MiB;
constexpr float SX8 = 8.f, SW8 = 32.f, SH8 = 16.f, SD8 = 16.f, SXN8 = 8.f, SWI8 = 32.f, SY8 = 64.f;
constexpr int NT_QKV = GA0 / 256;
constexpr size_t WS_WIN8 = WS_WIN;

constexpr int CW_TMO = 0, CW_BAR = 1024, CW_ECNT = 6144, CW_BCNT = 6176;

constexpr int RING_BYTES = 131072;
constexpr int LDSCTL_OFF = RING_BYTES, MISC_OFF = LDSCTL_OFF + 320;
constexpr int LDS_X_OFF = RING_BYTES + 1024;
constexpr int LDS_BYTES = 147456;
constexpr int NWAVES = 8;

#define LDS_WAIT() asm volatile("s_waitcnt lgkmcnt(0)" ::: "memory")
#define VM_WAIT() asm volatile("s_waitcnt vmcnt(0)" ::: "memory")
__device__ __forceinline__ unsigned f2bf(float f) { unsigned u = __builtin_bit_cast(unsigned, f); return (u + 0x7fffu + ((u >> 16) & 1u)) >> 16; }
__device__ __forceinline__ unsigned pk2(float lo, float hi) { return f2bf(lo) | (f2bf(hi) << 16); }
__device__ __forceinline__ float bf_lo(unsigned w) { return __builtin_bit_cast(float, w << 16); }
__device__ __forceinline__ float bf_hi(unsigned w) { return __builtin_bit_cast(float, w & 0xffff0000u); }
__device__ __forceinline__ float wave_sum(float v) {
#pragma unroll
    for (int o = 1; o < 64; o <<= 1) v += __shfl_xor(v, o);
    return v;
}
typedef int i32x4 __attribute__((ext_vector_type(4)));
typedef int i32x8 __attribute__((ext_vector_type(8)));
__device__ __forceinline__ unsigned pk8(float a, float b, float c, float d) {
    int w = __builtin_amdgcn_cvt_pk_fp8_f32(a, b, 0, false); w = __builtin_amdgcn_cvt_pk_fp8_f32(c, d, w, true); return (unsigned)w; }
__device__ __forceinline__ float wave_max(float v) {
#pragma unroll
    for (int o = 1; o < 64; o <<= 1) v = fmaxf(v, __shfl_xor(v, o));
    return v;
}
__device__ __forceinline__ unsigned pki8(float a, float b, float c, float d) {
    const int ia = (int)__builtin_rintf(a), ib = (int)__builtin_rintf(b), ic = (int)__builtin_rintf(c), id = (int)__builtin_rintf(d);
    return (unsigned)(ia & 255) | ((unsigned)(ib & 255) << 8) | ((unsigned)(ic & 255) << 16) | ((unsigned)id << 24); }
__device__ __forceinline__ float amax4(float m, const f32x4& v) { return fmaxf(fmaxf(m, fmaxf(fabsf(v[0]), fabsf(v[1]))), fmaxf(fabsf(v[2]), fabsf(v[3]))); }
#define NT_LDU4(p) __builtin_nontemporal_load((const GAS u32x4*)(p))
#define NT_LD4(p) __builtin_nontemporal_load((const GAS f32x4*)(p))
__device__ __forceinline__ unsigned ld_agent(const unsigned* p) { return __hip_atomic_load(p, RLX_AGENT); }
__device__ __forceinline__ float ld_agent_f(const float* p) { return __builtin_bit_cast(float, __hip_atomic_load((const unsigned*)p, RLX_AGENT)); }

namespace g8 {
constexpr int BM = 256, BK = 64, HALF = 128, HTB = HALF * BK * 2, NXCD = 8, WGM = 4;
__host__ __device__ __forceinline__ int lds_byte(int r, int c) { const int st = (r >> 4) * 2 + (c >> 5), rr = r & 15, cc = c & 31, ob = rr * 64 + cc * 2; return st * 1024 + (ob ^ (((ob >> 9) & 1) << 5)); }
__host__ __device__ __forceinline__ void stage_rc(int b, int& R, int& C) { const int st = b / 1024, sb = b % 1024, swz = sb ^ (((sb >> 9) & 1) << 5); R = (st >> 1) * 16 + swz / 64; C = (st & 1) * 32 + (swz % 64) / 2; }

struct Unit { const char* a; const char* b; const int* rows; int nkt; int pm, pn, x0, x1; };

__device__ __forceinline__ bool tile_order(int nM, int nN, int G, int c, int i, int& pm, int& pn) {
    const int nwg = nM * nN; const long L = (long)i * G + c; if (L >= nwg) return false;
    int wgid = (int)L; { const int q = nwg / NXCD, r = nwg % NXCD, xcd = wgid % NXCD, off = wgid / NXCD; wgid = (xcd < r ? xcd * (q + 1) : r * (q + 1) + (xcd - r) * q) + off; }
    const int nig = WGM * nN, gid = wgid / nig, fm = gid * WGM, gsz = (nM - fm) < WGM ? (nM - fm) : WGM;
    pm = fm + ((wgid % nig) % gsz); pn = (wgid % nig) / gsz; return true;
}

template <class Epi, class Sched, bool GATHER, bool FP8 = false, bool I8 = false>
__device__ __forceinline__ void gemm_phase(LAS unsigned char* lds, const int lda, const int ldb, const Sched& S, const Epi& E) {
    const int tid = threadIdx.x, wid = __builtin_amdgcn_readfirstlane(tid >> 6), lane = tid & 63, wr = wid >> 2, wc = wid & 3, fr = lane & 15, fq = lane >> 4;
    int Rr[2], Cc[2];
#pragma unroll
    for (int i = 0; i < 2; ++i) stage_rc(tid * 16 + i * 8192, Rr[i], Cc[i]);
    unsigned voffB[2], voffA[2];
#pragma unroll
    for (int i = 0; i < 2; ++i) { voffB[i] = (unsigned)(Rr[i] * ldb + Cc[i]) * 2u; voffA[i] = (unsigned)(Rr[i] * lda + Cc[i]) * 2u; }
    const size_t kstep = (size_t)(BK * 2);
    const size_t hstepA = (size_t)HALF * lda * 2, hstepB = (size_t)HALF * ldb * 2;
    const unsigned ldsw = (unsigned)wid * 1024u;
    const int aoff = lds_byte(wr * 64 + fr, fq * 8), boff = lds_byte(wc * 32 + fr, fq * 8);
    const int aoff8 = lds_byte(wr * 64 + fr, 16 * (fq & 1)) + (fq >> 1) * 1024, boff8 = lds_byte(wc * 32 + fr, 16 * (fq & 1)) + (fq >> 1) * 1024;
#define G8_SA(b, h) (((b) * 2 + (h)) * HTB)
#define G8_SB(b, h) ((4 + (b) * 2 + (h)) * HTB)
#define G8_STAGE(bufoff, gbase, voff) do { _Pragma("unroll") for (int _i = 0; _i < 2; ++_i) \
        __builtin_amdgcn_global_load_lds((const unsigned*)((const char*)(gbase) + (voff)[_i]), (LAS unsigned*)(lds + (bufoff) + ldsw + _i * 8192), 16, 0, 0); } while (0)
#define G8_STAGE_A(bufoff, gbase, h, va) do { if (GATHER) { G8_STAGE(bufoff, gbase, (va)[h]); } else { G8_STAGE(bufoff, (gbase) + (h) * hstepA, voffA); } } while (0)
#define G8_STAGE_B(bufoff, gbase, h) G8_STAGE(bufoff, (gbase) + (h) * hstepB, voffB)
#define G8_LD8(p) (*(const LAS i32x8*)(p))
#define G8_LDA(dst, b, h) do { _Pragma("unroll") for (int m = 0; m < 4; ++m) { if (FP8) dst##8[m] = G8_LD8(lds + G8_SA(b, h) + aoff8 + m * 2048); else { _Pragma("unroll") for (int k = 0; k < 2; ++k) dst[m][k] = *(const LAS bf16x8*)(lds + G8_SA(b, h) + aoff + m * 2048 + k * 1024); } } } while (0)
#define G8_LDB(dst, b, h) do { _Pragma("unroll") for (int n = 0; n < 2; ++n) { if (FP8) dst##8[n] = G8_LD8(lds + G8_SB(b, h) + boff8 + n * 2048); else { _Pragma("unroll") for (int k = 0; k < 2; ++k) dst[n][k] = *(const LAS bf16x8*)(lds + G8_SB(b, h) + boff + n * 2048 + k * 1024); } } } while (0)
#define G8_CAT(x0, x1) __builtin_shufflevector(__builtin_bit_cast(i32x4, x0), __builtin_bit_cast(i32x4, x1), 0, 1, 2, 3, 4, 5, 6, 7)
#define G8_MMA(ai, bj, At, Bt) do { __builtin_amdgcn_s_setprio(1); _Pragma("unroll") for (int m = 0; m < 4; ++m) _Pragma("unroll") for (int n = 0; n < 2; ++n) { \
        if (FP8) asm volatile("v_mfma_scale_f32_16x16x128_f8f6f4 %0, %1, %2, %0, %3, %3 op_sel_hi:[0,0,0]" : "+v"(acc[ai][bj][m][n]) : "v"(Bt##8[n]), "v"(At##8[m]), "v"(one8));     \
        else if (I8) { _Pragma("unroll") for (int k = 0; k < 2; ++k) acc[ai][bj][m][n] = __builtin_bit_cast(f32x4, __builtin_amdgcn_mfma_i32_16x16x64_i8(__builtin_bit_cast(i32x4, Bt[n][k]), __builtin_bit_cast(i32x4, At[m][k]), __builtin_bit_cast(i32x4, acc[ai][bj][m][n]), 0, 0, 0)); }     \
        else { _Pragma("unroll") for (int k = 0; k < 2; ++k) acc[ai][bj][m][n] = __builtin_amdgcn_mfma_f32_16x16x32_bf16(Bt[n][k], At[m][k], acc[ai][bj][m][n], 0, 0, 0); } } \
        __builtin_amdgcn_s_setprio(0); } while (0)
#define G8_WAIT_V(n) asm volatile("s_waitcnt vmcnt(" #n ")" ::: "memory")
#define G8_WAIT_L(n) asm volatile("s_waitcnt lgkmcnt(" #n ")" ::: "memory")
#define G8_BAR __builtin_amdgcn_s_barrier()
#define G8_SCHED __builtin_amdgcn_sched_barrier(0)
#define G8_AOFF(dst, u) do { int _t = tid; asm volatile("" : "+v"(_t)); _Pragma("unroll") for (int _i = 0; _i < 2; ++_i) { int _R, _C; stage_rc(_t * 16 + _i * 8192, _R, _C); \
        _Pragma("unroll") for (int _h = 0; _h < 2; ++_h) { const int _r = (int)ld_agent((const unsigned*)((u).rows + _h * HALF + _R)); dst[_h][_i] = (unsigned)(_r * lda + _C) * 2u; } } } while (0)
    Unit cur, nxt; int ui = 0;
    if (!S.next(0, cur)) return;
    unsigned cva[2][2], nva[2][2];
    if (GATHER) { G8_AOFF(cva, cur); }
    f32x4 acc[2][2][4][2];
#pragma unroll
    for (int a = 0; a < 2; ++a)
#pragma unroll
        for (int b = 0; b < 2; ++b)
#pragma unroll
            for (int m = 0; m < 4; ++m)
#pragma unroll
                for (int n = 0; n < 2; ++n) acc[a][b][m][n] = (f32x4){0.f, 0.f, 0.f, 0.f};
    bf16x8 At[4][2], B0[2][2], B1[2][2]; i32x8 At8[4], B08[2], B18[2]; const int one8 = 0x7f7f7f7f;
    const char* cA = cur.a; const char* cB = cur.b;
    G8_STAGE_B(G8_SB(0, 0), cB, 0); G8_STAGE_B(G8_SB(0, 1), cB, 1); G8_STAGE_A(G8_SA(0, 0), cA, 0, cva); G8_STAGE_A(G8_SA(0, 1), cA, 1, cva);
    if (wr == 1) G8_BAR;
    G8_WAIT_V(2); G8_BAR;
    G8_STAGE_B(G8_SB(1, 0), cB + kstep, 0); G8_STAGE_A(G8_SA(1, 0), cA + kstep, 0, cva); G8_STAGE_B(G8_SB(1, 1), cB + kstep, 1);
    G8_WAIT_V(6); G8_BAR;
    for (;;) {
        const bool has_next = S.next(ui + 1, nxt);
        const char* nA = has_next ? nxt.a : cA; const char* nB = has_next ? nxt.b : cB;
        if (GATHER) { if (has_next) { G8_AOFF(nva, nxt); } else {
#pragma unroll
            for (int h = 0; h < 2; ++h) { nva[h][0] = cva[h][0]; nva[h][1] = cva[h][1]; } } }
        const int nt = cur.nkt;
        for (int t = 0; t < nt; t += 2) {
            const bool last = (t == nt - 2);
            const char* a1 = cA + (size_t)(t + 1) * kstep;
            const char* a2 = last ? nA : cA + (size_t)(t + 2) * kstep; const char* b2 = last ? nB : cB + (size_t)(t + 2) * kstep;
            const char* a3 = a2 + kstep; const char* b3 = b2 + kstep;
            unsigned va2[2][2];
#pragma unroll
            for (int h = 0; h < 2; ++h)
#pragma unroll
                for (int i = 0; i < 2; ++i) va2[h][i] = (GATHER && last) ? nva[h][i] : cva[h][i];
            G8_LDB(B0, 0, 0); G8_LDB(B1, 0, 1); G8_SCHED; G8_LDA(At, 0, 0); G8_STAGE_A(G8_SA(1, 1), a1, 1, cva);
            G8_WAIT_V(8); G8_WAIT_L(0); G8_BAR; G8_MMA(0, 0, At, B0); G8_MMA(0, 1, At, B1); G8_BAR; G8_SCHED;
            G8_LDA(At, 0, 1); G8_STAGE_B(G8_SB(0, 0), b2, 0); G8_STAGE_B(G8_SB(0, 1), b2, 1); G8_STAGE_A(G8_SA(0, 0), a2, 0, va2);
            G8_WAIT_V(8); G8_WAIT_L(0); G8_BAR; G8_MMA(1, 0, At, B0); G8_MMA(1, 1, At, B1); G8_BAR; G8_SCHED;
            G8_LDB(B0, 1, 0); G8_LDB(B1, 1, 1); G8_SCHED; G8_LDA(At, 1, 0); G8_STAGE_A(G8_SA(0, 1), a2, 1, va2);
            G8_WAIT_V(8); G8_WAIT_L(0); G8_BAR; G8_MMA(0, 0, At, B0); G8_MMA(0, 1, At, B1); G8_BAR; G8_SCHED;
            G8_LDA(At, 1, 1); G8_STAGE_B(G8_SB(1, 0), b3, 0); G8_STAGE_B(G8_SB(1, 1), b3, 1); G8_STAGE_A(G8_SA(1, 0), a3, 0, va2);
            G8_WAIT_V(8); G8_WAIT_L(0); G8_BAR; G8_MMA(1, 0, At, B0); G8_MMA(1, 1, At, B1); G8_BAR; G8_SCHED;
        }
        if (FP8) asm volatile("s_nop 15\n\ts_nop 15" ::: "memory");
        if (wr == 0) G8_BAR;
        const bool keep = E(acc, cur, wr, wc, fr, fq);
        if (!has_next) break;
        if (!keep) {
#pragma unroll
            for (int a = 0; a < 2; ++a)
#pragma unroll
                for (int b = 0; b < 2; ++b)
#pragma unroll
                    for (int m = 0; m < 4; ++m)
#pragma unroll
                        for (int n = 0; n < 2; ++n) acc[a][b][m][n] = (f32x4){0.f, 0.f, 0.f, 0.f};
        }
        cur = nxt; cA = nA; cB = nB; ++ui;
        if (GATHER) {
#pragma unroll
            for (int h = 0; h < 2; ++h) { cva[h][0] = nva[h][0]; cva[h][1] = nva[h][1]; } }
        if (wr == 1) G8_BAR;
    }
    G8_WAIT_V(0);
    G8_BAR;
#undef G8_SA
#undef G8_SB
#undef G8_STAGE
#undef G8_STAGE_A
#undef G8_STAGE_B
#undef G8_LDA
#undef G8_LD8
#undef G8_LDB
#undef G8_MMA
#undef G8_CAT
#undef G8_WAIT_V
#undef G8_WAIT_L
#undef G8_BAR
#undef G8_SCHED
#undef G8_AOFF
}
}

#define XB_TMO      128
#define XB_XCNT(j)  (256  + 64 * (j))
#define XB_XSUB(j)  (1280 + 64 * (j))
#define XB_XGEN(j)  (2304 + 64 * (j))
#define XB_TOP      3328
#define XB_TOPGEN   3392
#define XCD_BAR_WORDS 3456
#define XB_SPIN_CAP (1u << 18)
__device__ __forceinline__ unsigned xb_ld(unsigned* p)              { return __hip_atomic_load(p, __ATOMIC_RELAXED, __HIP_MEMORY_SCOPE_AGENT); }
__device__ __forceinline__ unsigned xb_add(unsigned* p, unsigned v) { return __hip_atomic_fetch_add(p, v, __ATOMIC_RELAXED, __HIP_MEMORY_SCOPE_AGENT); }
__device__ __forceinline__ unsigned xb_xcc_id() { return (unsigned)__builtin_amdgcn_s_getreg((3 << 11) | 20) & 0xFu; }
#define XB_SPIN(cond, bar) do { unsigned _sp = 0; while (cond) { __builtin_amdgcn_s_sleep(1); \
    if ((++_sp & 255u) == 0u) { if (xb_ld(&(bar)[XB_TMO])) break; if (_sp > XB_SPIN_CAP) { atomicAdd(&(bar)[XB_TMO], 1u); break; } } } } while (0)
struct XcdBarrier { unsigned* bar; unsigned x; volatile LAS unsigned* st; };
__device__ __forceinline__ XcdBarrier xcd_barrier_post(unsigned* bar, volatile LAS unsigned* st) {
    XcdBarrier b; b.bar = bar; b.x = xb_xcc_id(); b.st = st;
    if (threadIdx.x == 0) (void)xb_add(&bar[XB_XCNT(b.x)], 1u);
    return b;
}
__device__ __forceinline__ void xcd_barrier_complete(unsigned* bar, unsigned x, unsigned& nloc, unsigned& nx) {
    const unsigned G = gridDim.x * gridDim.y * gridDim.z;
    unsigned sum, cnt, mine, sp = 0u;
    for (;;) {
        sum = 0u; cnt = 0u; mine = 0u;
#pragma unroll
        for (unsigned j = 0; j < 16; ++j) { const unsigned c = xb_ld(&bar[XB_XCNT(j)]); sum += c; cnt += (c > 0u) ? 1u : 0u; mine = (j == x) ? c : mine; }
        if (sum == G) break;
        __builtin_amdgcn_s_sleep(1);
        if ((++sp & 255u) == 0u) { if (xb_ld(&bar[XB_TMO])) break; if (sp > XB_SPIN_CAP) { atomicAdd(&bar[XB_TMO], 1u); break; } }
    }
    nloc = mine > 0u ? mine : 1u; nx = cnt > 0u ? cnt : 1u;
}
__device__ __forceinline__ void xcd_barrier(const XcdBarrier& b) {
    asm volatile("s_waitcnt vmcnt(0)" ::: "memory");
    __syncthreads();
    if (threadIdx.x == 0) {
        unsigned* bar = b.bar;
        __builtin_amdgcn_s_waitcnt(0);
        unsigned nloc = b.st[0], nx = b.st[1];
        if (nloc == 0u) { xcd_barrier_complete(bar, b.x, nloc, nx); b.st[0] = nloc; b.st[1] = nx; }
        const unsigned old = xb_add(&bar[XB_XSUB(b.x)], 1u);
        const unsigned gen = old / nloc;
        if (old + 1u == (gen + 1u) * nloc) {
            __builtin_amdgcn_fence(__ATOMIC_RELEASE, "agent");
            asm volatile("s_waitcnt vmcnt(0)" ::: "memory");
            const unsigned og = xb_add(&bar[XB_TOP], 1u);
            const unsigned tg = og / nx;
            if (og + 1u == (tg + 1u) * nx) xb_add(&bar[XB_TOPGEN], 1u);
            else XB_SPIN(xb_ld(&bar[XB_TOPGEN]) == tg, bar);
            __builtin_amdgcn_fence(__ATOMIC_ACQUIRE, "agent");
            xb_add(&bar[XB_XGEN(b.x)], 1u);
            asm volatile("s_waitcnt vmcnt(0)" ::: "memory");
        } else {
            XB_SPIN(xb_ld(&bar[XB_XGEN(b.x)]) == gen, bar);
            __builtin_amdgcn_fence(__ATOMIC_ACQUIRE, "agent");
            asm volatile("s_waitcnt vmcnt(0)" ::: "memory");
        }
    }
    __syncthreads();
}

struct Args { const float* in[17]; float* out; unsigned char* ws; int ph_lo, ph_hi; };

struct Frame {
    LAS unsigned char* lds;
    int tid, lane, wave, vcu, G;
    const float *x, *g_mix, *w_in, *qn_a, *kn_a, *sinks, *qn_b, *kn_b, *w_upa, *w_upb, *w_out, *g_ffn, *w_rg, *w_re, *w_ge, *w_ue, *w_de;
    float* out; unsigned char* ws;
};

__device__ __forceinline__ int perm_in(int j) { return 16 * ((j >> 2) & 1) + 4 * (j >> 3) + (j & 3); }

struct CvItem { const float* src; bf16_t* dst; int ldw, ldt; const float* gk; float sc8; };
__device__ __forceinline__ void cv_load(f32x4 (&v)[8], const CvItem& it, int lane) {
#pragma unroll
    for (int j = 0; j < 8; ++j) v[j] = NT_LD4(it.src + (size_t)((lane >> 3) + 8 * j) * it.ldw + 4 * (lane & 7));
    if (it.gk) {
#pragma unroll
        for (int j = 0; j < 8; ++j) v[j] = v[j] * it.gk[(lane >> 3) + 8 * j]; }
    if (it.sc8 != 0.f) {
#pragma unroll
        for (int j = 0; j < 8; ++j) v[j] = v[j] * it.sc8; }
}
__device__ __forceinline__ void cv_to_lds(const f32x4 (&v)[8], LAS float* scr, int lane) {
#pragma unroll
    for (int j = 0; j < 8; ++j) { LAS float* d = scr + ((lane >> 3) + 8 * j) * 33 + 4 * (lane & 7); d[0] = v[j][0]; d[1] = v[j][1]; d[2] = v[j][2]; d[3] = v[j][3]; }
}
__device__ __forceinline__ void cv_store(const CvItem& it, const LAS float* scr, int lane) {
    const int c = lane & 7;
    if (it.sc8 != 0.f) {
#pragma unroll
        for (int j = 0; j < 4; ++j) { const int n = (lane >> 3) + 8 * j; const LAS float* s = scr + (8 * c) * 33 + n;
            u32x2 o; o.x = pk8(s[0 * 33], s[1 * 33], s[2 * 33], s[3 * 33]); o.y = pk8(s[4 * 33], s[5 * 33], s[6 * 33], s[7 * 33]);
            *(GAS u32x2*)((unsigned char*)it.dst + (size_t)perm_in(n) * it.ldt + 8 * c) = o; }
        return; }
#pragma unroll
    for (int j = 0; j < 4; ++j) { const int n = (lane >> 3) + 8 * j; const LAS float* s = scr + (8 * c) * 33 + n;
        u32x4 o; o.x = pk2(s[0 * 33], s[1 * 33]); o.y = pk2(s[2 * 33], s[3 * 33]); o.z = pk2(s[4 * 33], s[5 * 33]); o.w = pk2(s[6 * 33], s[7 * 33]);
        *(GAS u32x4*)(it.dst + (size_t)perm_in(n) * it.ldt + 8 * c) = o; }
}
template <class Dec> __device__ __forceinline__ void convert_list(const Dec& dec, int gw, int NGW, int N, LAS float* scr, int lane) {
    if (gw >= N) return;
    f32x4 v[8]; CvItem cur = dec(gw); cv_load(v, cur, lane);
    for (int it = gw; it < N; it += NGW) {
        cv_to_lds(v, scr, lane);
        const int nx = it + NGW; CvItem nxt = cur; if (nx < N) { nxt = dec(nx); cv_load(v, nxt, lane); }
        LDS_WAIT(); asm volatile("" ::: "memory");
        cv_store(cur, scr, lane);
        LDS_WAIT(); asm volatile("" ::: "memory");
        cur = nxt;
    }
}
__device__ __forceinline__ int std_row0(int n0) { return (n0 & ~255) + 128 * ((n0 >> 5) & 1) + 32 * ((n0 >> 6) & 3); }

__device__ __forceinline__ void convert_w_in_i8(const Frame& F, int nb) {
    LAS float* scr = (LAS float*)(F.lds + F.wave * 16384);
    volatile LAS float* red = (volatile LAS float*)(F.lds + 12288);
    const int lane = F.lane, w = F.wave;
    const float* src = F.w_in + (size_t)(256 * w + (lane >> 3)) * INC + 32 * nb + 4 * (lane & 7);
    f32x4 v[4][8];
#pragma unroll
    for (int it = 0; it < 4; ++it)
#pragma unroll
        for (int j = 0; j < 8; ++j) v[it][j] = NT_LD4(src + (size_t)(64 * it + 8 * j) * INC);
    float am = 0.f;
#pragma unroll
    for (int it = 0; it < 4; ++it)
#pragma unroll
        for (int j = 0; j < 8; ++j) am = amax4(am, v[it][j]);
    am = wave_max(am);
    __syncthreads();
    if (lane == 0) red[w] = am;
    __syncthreads();
    float gmx = red[0];
#pragma unroll
    for (int i = 1; i < NWAVES; ++i) gmx = fmaxf(gmx, red[i]);
    const float sc = gmx > 0.f ? 127.f / gmx : 0.f;
    if (F.tid == 0) ((float*)(F.ws + WS_WSC))[nb] = gmx * (1.f / 127.f);
    int row0;
    if (32 * nb >= GA0) { const int n1 = 32 * nb - GA0, isb = n1 >> 11, mc0 = n1 & (DM - 1); row0 = GA0 + (mc0 >> 7) * 256 + 128 * isb + 32 * ((mc0 >> 5) & 3); }
    else row0 = std_row0(32 * nb);
    unsigned char* dst = F.ws + WS_WIN8 + (size_t)row0 * DM + 256 * w;
    const int c = lane & 7;
#pragma unroll
    for (int it = 0; it < 4; ++it) {
#pragma unroll
        for (int j = 0; j < 8; ++j) { LAS float* d = scr + ((lane >> 3) + 8 * j) * 33 + 4 * c; const f32x4 q = v[it][j] * sc; d[0] = q[0]; d[1] = q[1]; d[2] = q[2]; d[3] = q[3]; }
        LDS_WAIT(); asm volatile("" ::: "memory");
#pragma unroll
        for (int j = 0; j < 4; ++j) { const int n = (lane >> 3) + 8 * j; const LAS float* sp = scr + (8 * c) * 33 + n;
            u32x2 o; o.x = pki8(sp[0 * 33], sp[1 * 33], sp[2 * 33], sp[3 * 33]); o.y = pki8(sp[4 * 33], sp[5 * 33], sp[6 * 33], sp[7 * 33]);
            *(GAS u32x2*)(dst + 64 * it + (size_t)perm_in(n) * DM + 8 * c) = o; }
        LDS_WAIT(); asm volatile("" ::: "memory");
    }
}

__device__ __forceinline__ void p0_prologue(const Frame& F) {
    LAS float* scr = (LAS float*)(F.lds + F.wave * 16384);
    bf16_t* Wup_t = (bf16_t*)(F.ws + WS_WUP); bf16_t* Wout_t = (bf16_t*)(F.ws + WS_WOUT);
    constexpr int NGRP = INC / 32;
    for (int nb = F.vcu; nb < NGRP; nb += F.G) convert_w_in_i8(F, nb);
    const int nheavy = (F.G < NGRP && 2 * (NGRP % F.G) <= F.G) ? NGRP % F.G : 0;
    if (F.vcu >= nheavy) {
    const int gw = (F.vcu - nheavy) * NWAVES + F.wave, NGW = (F.G - nheavy) * NWAVES;
    constexpr int I_UP = (1024 / 64) * (DM / 32);
    constexpr int I_OUT = (DM / 64) * (DM / 32);
    constexpr int NITEMS = 2 * I_UP + I_OUT;
    struct Dec0 { const float *w_upa, *w_upb, *w_out; bf16_t *Wup_t, *Wout_t;
        __device__ __forceinline__ CvItem operator()(int r) const {
            if (r < 2 * I_UP) { const int half = r / I_UP; r -= half * I_UP; const int nblk = DM / 32, kb = r / nblk, nb = r % nblk;
                return CvItem{(half ? w_upb : w_upa) + (size_t)(64 * kb) * DM + 32 * nb, Wup_t + (size_t)half * DM * 1024 + (size_t)std_row0(32 * nb) * 1024 + 64 * kb, DM, 1024, nullptr, 0.f}; } r -= 2 * I_UP;
            const int nblk = DM / 32, kb = r / nblk, nb = r % nblk; return CvItem{w_out + (size_t)(64 * kb) * DM + 32 * nb, Wout_t + (size_t)std_row0(32 * nb) * DM + 64 * kb, DM, DM, nullptr, 0.f}; } };
    convert_list(Dec0{F.w_upa, F.w_upb, F.w_out, Wup_t, Wout_t}, gw, NGW, NITEMS, scr, F.lane);
    f32x4 gm[8];
#pragma unroll
    for (int j = 0; j < 8; ++j) gm[j] = ((const GAS f32x4*)F.g_mix)[F.lane + 64 * j];
    for (int m = gw; m < NTOK; m += NGW) {
        const GAS f32x4* xr = (const GAS f32x4*)(F.x + (size_t)m * DM) + F.lane;
        f32x4 v[8]; float s = 0.f;
#pragma unroll
        for (int j = 0; j < 8; ++j) { v[j] = NT_LD4(xr + 64 * j); s += (v[j].x * v[j].x + v[j].y * v[j].y) + (v[j].z * v[j].z + v[j].w * v[j].w); }
        const float rstd = 1.0f / sqrtf(wave_sum(s) * (1.f / DM) + EPS);
        float am = 0.f;
#pragma unroll
        for (int j = 0; j < 8; ++j) { v[j] = v[j] * rstd * gm[j]; am = amax4(am, v[j]); }
        am = wave_max(am);
        const float sc = am > 0.f ? 127.f / am : 0.f;
        if (F.lane == 0) ((float*)(F.ws + WS_XS))[m] = am * (1.f / 127.f);
#pragma unroll
        for (int j = 0; j < 8; ++j) { const f32x4 y = v[j] * sc; ((GAS unsigned*)(F.ws + WS_X8 + (size_t)m * DM))[F.lane + 64 * j] = pki8(y.x, y.y, y.z, y.w); }
    }
    }
    { bf16_t* GWT = (bf16_t*)(F.ws + WS_GWT);
      for (int idx = F.vcu * 512 + F.tid; idx < 32 * DM; idx += F.G * 512) { const int j = idx >> 11, d = idx & (DM - 1); float v = 0.f;
          if (j < 4) v = F.w_rg[d * 4 + j]; else if (j < 20) v = F.w_re[((size_t)((j - 4) >> 2) * DM + d) * 4 + ((j - 4) & 3)];
          GWT[idx] = (bf16_t)f2bf(v * F.g_ffn[d]); } }
    { GAS u32x4* z = (GAS u32x4*)(F.ws + WS_SL); for (int i = F.vcu * 512 + F.tid; i < (int)(2 * MiB / 16); i += F.G * 512) z[i] = (u32x4){0u, 0u, 0u, 0u}; }
    { GAS u32x4* z = (GAS u32x4*)(F.ws + WS_BK); for (int i = F.vcu * 512 + F.tid; i < (int)(BK_BYTES / 16); i += F.G * 512) z[i] = (u32x4){0u, 0u, 0u, 0u}; }
    float* KS = (float*)(F.ws + WS_KSUM);
    for (int i = F.vcu * 512 + F.tid; i < NB * 16 * 8 * 64; i += F.G * 512) KS[i] = 0.f;
}

struct CvBlock { const float* src; unsigned char* dst; const float* gk; int kind, e, isup, nblk; };
template <class Dec> __device__ __forceinline__ void convert_blocks_fp8(const Frame& F, const Dec& dec, int wg, int nwg, int nblocks, int ldw, int ldt, float sc) {
    if (wg >= nblocks) return;
    LAS unsigned char* T = F.lds;
    const int lane = F.lane, w = F.wave;
    f32x4 v[16]; float gl;
    CvBlock cur = dec(wg);
#define CVB_LOAD(blk) do { const float* _s = (blk).src + (size_t)(16 * w) * ldw + 4 * lane; _Pragma("unroll") for (int j = 0; j < 16; ++j) v[j] = NT_LD4(_s + (size_t)j * ldw); \
        gl = (blk).gk ? (blk).gk[16 * w + (lane & 15)] * sc : sc; } while (0)
    CVB_LOAD(cur);
    for (int it = wg; it < nblocks; it += nwg) {
        const int sw = 16 * (lane & 7);
#pragma unroll
        for (int q = 0; q < 4; ++q) {
            const float g0 = __builtin_bit_cast(float, __builtin_amdgcn_readlane(__builtin_bit_cast(int, gl), 4 * q)), g1 = __builtin_bit_cast(float, __builtin_amdgcn_readlane(__builtin_bit_cast(int, gl), 4 * q + 1)),
                        g2 = __builtin_bit_cast(float, __builtin_amdgcn_readlane(__builtin_bit_cast(int, gl), 4 * q + 2)), g3 = __builtin_bit_cast(float, __builtin_amdgcn_readlane(__builtin_bit_cast(int, gl), 4 * q + 3));
#pragma unroll
            for (int i = 0; i < 4; ++i) *(LAS unsigned*)(T + (4 * lane + i) * 128 + ((16 * w + 4 * q) ^ sw)) = pk8(v[4 * q][i] * g0, v[4 * q + 1][i] * g1, v[4 * q + 2][i] * g2, v[4 * q + 3][i] * g3);
        }
        const int nx = it + nwg; CvBlock nxt = cur; if (nx < nblocks) { nxt = dec(nx); CVB_LOAD(nxt); }
        LDS_WAIT(); asm volatile("" ::: "memory"); __builtin_amdgcn_s_barrier(); asm volatile("" ::: "memory");
#pragma unroll
        for (int r = 0; r < 4; ++r) { const int n = 32 * w + 8 * r + (lane >> 3), c = lane & 7;
            const u32x4 d = *(const LAS u32x4*)(T + n * 128 + ((16 * c) ^ (16 * ((n >> 2) & 7))));
            int row; if (cur.kind == 0) { const int hc = 256 * cur.nblk + n; row = (hc >> 7) * 256 + 128 * cur.isup + 32 * ((hc >> 5) & 3) + perm_in(hc & 31); } else { const int col = 256 * cur.nblk + n; row = std_row0(col & ~31) + perm_in(col & 31); }
            *(GAS u32x4*)(cur.dst + (size_t)row * ldt + 16 * c) = d; }
        LDS_WAIT(); asm volatile("" ::: "memory"); __builtin_amdgcn_s_barrier(); asm volatile("" ::: "memory");
        cur = nxt;
    }
#undef CVB_LOAD
}
__device__ __forceinline__ void convert_moe_gate_up(const Frame& F, int wg, int nwg) {
    struct Dec { const float *w_ge, *w_ue, *g_ffn; unsigned char* Wgu;
        __device__ __forceinline__ CvBlock operator()(int r) const { const int nblk = r & 1, kb = (r >> 1) & 15, e = (r >> 5) & 15, isup = r >> 9;
            return CvBlock{(isup ? w_ue : w_ge) + (size_t)e * DM * DEXP + (size_t)(128 * kb) * DEXP + 256 * nblk, Wgu + (size_t)e * 1024 * DM + 128 * kb, g_ffn + 128 * kb, 0, e, isup, nblk}; } };
    convert_blocks_fp8(F, Dec{F.w_ge, F.w_ue, F.g_ffn, F.ws + WS_WGU}, wg, nwg, 2 * NEXP * 16 * 2, DEXP, DM, SW8);
}
__device__ __forceinline__ void convert_moe_down(const Frame& F, int wg, int nwg) {
    struct Dec { const float* w_de; unsigned char* Wd;
        __device__ __forceinline__ CvBlock operator()(int r) const { const int nblk = r & 7, kb = (r >> 3) & 3, e = r >> 5;
            return CvBlock{w_de + (size_t)e * DEXP * DM + (size_t)(128 * kb) * DM + 256 * nblk, Wd + (size_t)e * DM * DEXP + 128 * kb, nullptr, 1, e, 0, nblk}; } };
    convert_blocks_fp8(F, Dec{F.w_de, F.ws + WS_WD}, wg, nwg, NEXP * 4 * 8, DM, DEXP, SD8);
}

struct SchedTiles {
    const char* A; const char* Bt; int nM, nN, K, G, c;
    __device__ __forceinline__ bool next(int i, g8::Unit& u) const {
        int pm, pn; if (!g8::tile_order(nM, nN, G, c, i, pm, pn)) return false;
        u.a = A + (size_t)pm * 256 * K * 2; u.b = Bt + (size_t)pn * 256 * K * 2; u.rows = nullptr; u.nkt = K / 64; u.pm = pm; u.pn = pn; u.x0 = 0; u.x1 = 0; return true;
    }
};
struct SchedIn8 {
    const char* A; const char* Bt; int G, c;
    __device__ __forceinline__ bool next(int i, g8::Unit& u) const {
        int pm, pn; if (!g8::tile_order(NTOK / 256, INC / 256, G, c, i, pm, pn)) return false;
        u.a = A + (size_t)pm * 256 * DM; u.b = Bt + (size_t)pn * 256 * DM; u.rows = nullptr; u.nkt = DM / 128; u.pm = pm; u.pn = pn; u.x0 = 0; u.x1 = 0; return true;
    }
};
struct EpiGate8 {
    bf16_t* P; const float* XS; const float* WSC;
    __device__ __forceinline__ bool operator()(f32x4 (&acc)[2][2][4][2], const g8::Unit& u, int wr, int wc, int fr, int fq) const {
        const int t = u.pn - NT_QKV, mcol = t * 128 + wc * 32 + 8 * fq;
        const float wa = ld_agent_f(WSC + GA0 / 32 + 4 * t + wc) * -LOG2E, wb = ld_agent_f(WSC + GB0 / 32 + 4 * t + wc) * -LOG2E;
#pragma unroll
        for (int ai = 0; ai < 2; ++ai)
#pragma unroll
            for (int m = 0; m < 4; ++m) { const int row = u.pm * 256 + ai * 128 + wr * 64 + m * 16 + fr;
                const float xr = ld_agent_f(XS + row), sa_ = xr * wa, sb_ = xr * wb;
                float rr[8], sbv[8];
#pragma unroll
                for (int n = 0; n < 2; ++n) { const i32x4 ia = __builtin_bit_cast(i32x4, acc[ai][0][m][n]), ib = __builtin_bit_cast(i32x4, acc[ai][1][m][n]);
#pragma unroll
                    for (int i = 0; i < 4; ++i) { const float ea = 1.0f + __builtin_amdgcn_exp2f((float)ia[i] * sa_), eb = 1.0f + __builtin_amdgcn_exp2f((float)ib[i] * sb_);
                        rr[4 * n + i] = eb * __builtin_amdgcn_rcpf(ea); sbv[4 * n + i] = __builtin_amdgcn_rcpf(eb); } }
                u32x4 wr_, ws_; wr_.x = pk2(rr[0], rr[1]); wr_.y = pk2(rr[2], rr[3]); wr_.z = pk2(rr[4], rr[5]); wr_.w = pk2(rr[6], rr[7]);
                ws_.x = pk2(sbv[0], sbv[1]); ws_.y = pk2(sbv[2], sbv[3]); ws_.z = pk2(sbv[4], sbv[5]); ws_.w = pk2(sbv[6], sbv[7]);
                *(GAS u32x4*)(P + (size_t)row * INC + GA0 + mcol) = wr_; *(GAS u32x4*)(P + (size_t)row * INC + GB0 + mcol) = ws_; }
        return false;
    }
};
struct EpiProj {
    bf16_t* P; float* KS; const float *qn_a, *kn_a, *qn_b, *kn_b; const float* XS; const float* WSC;
    __device__ __forceinline__ bool operator()(f32x4 (&acc)[2][2][4][2], const g8::Unit& u, int wr, int wc, int fr, int fq) const {
        const int pn = u.pn;
        int kind; const float* gain = nullptr;
        if (pn < 4) { kind = 2; gain = qn_a; } else if (pn == 4) { if (wc < 2) { kind = 1; gain = kn_a; } else kind = 0; }
        else if (pn < 9) { kind = 2; gain = qn_b; } else if (pn < 13) { kind = 3; gain = kn_b; } else kind = 0;
        const int colbase = pn * 256 + wc * 64 + 8 * fq;
        { const float w0 = ld_agent_f(WSC + pn * 8 + wc * 2), w1 = ld_agent_f(WSC + pn * 8 + wc * 2 + 1);
#pragma unroll
          for (int ai = 0; ai < 2; ++ai)
#pragma unroll
              for (int m = 0; m < 4; ++m) { const float xr = ld_agent_f(XS + u.pm * 256 + ai * 128 + wr * 64 + m * 16 + fr);
#pragma unroll
                  for (int bj = 0; bj < 2; ++bj) { const float sc = xr * (bj ? w1 : w0);
#pragma unroll
                      for (int n = 0; n < 2; ++n) { const i32x4 iv = __builtin_bit_cast(i32x4, acc[ai][bj][m][n]); acc[ai][bj][m][n] = (f32x4){(float)iv[0] * sc, (float)iv[1] * sc, (float)iv[2] * sc, (float)iv[3] * sc}; } } } }
        f32x4 gv[2][2];
        if (kind != 0) {
#pragma unroll
            for (int bj = 0; bj < 2; ++bj)
#pragma unroll
                for (int n = 0; n < 2; ++n) gv[bj][n] = *(const GAS f32x4*)(gain + 32 * bj + 8 * fq + 4 * n);
            if (kind == 2) {
#pragma unroll
                for (int bj = 0; bj < 2; ++bj)
#pragma unroll
                    for (int n = 0; n < 2; ++n) gv[bj][n] = gv[bj][n] * QSCALE;
            }
        }
        f32x4 ks[2][2];
#pragma unroll
        for (int bj = 0; bj < 2; ++bj)
#pragma unroll
            for (int n = 0; n < 2; ++n) ks[bj][n] = (f32x4){0.f, 0.f, 0.f, 0.f};
#pragma unroll
        for (int ai = 0; ai < 2; ++ai)
#pragma unroll
            for (int m = 0; m < 4; ++m) { const int row = u.pm * 256 + ai * 128 + wr * 64 + m * 16 + fr;
                if (kind != 0) {
                    float s = 0.f;
#pragma unroll
                    for (int bj = 0; bj < 2; ++bj)
#pragma unroll
                        for (int n = 0; n < 2; ++n) { const f32x4 v = acc[ai][bj][m][n]; s += (v[0] * v[0] + v[1] * v[1]) + (v[2] * v[2] + v[3] * v[3]); }
                    s += __shfl_xor(s, 16); s += __shfl_xor(s, 32);
                    const float rstd = 1.0f / sqrtf(s * (1.f / 64.f) + EPS);
#pragma unroll
                    for (int bj = 0; bj < 2; ++bj)
#pragma unroll
                        for (int n = 0; n < 2; ++n) { acc[ai][bj][m][n] = acc[ai][bj][m][n] * rstd * gv[bj][n]; if (kind == 3) ks[bj][n] += acc[ai][bj][m][n]; }
                }
#pragma unroll
                for (int bj = 0; bj < 2; ++bj) { u32x4 w; const f32x4 a = acc[ai][bj][m][0], b = acc[ai][bj][m][1];
                    w.x = pk2(a[0], a[1]); w.y = pk2(a[2], a[3]); w.z = pk2(b[0], b[1]); w.w = pk2(b[2], b[3]);
                    *(GAS u32x4*)(P + (size_t)row * INC + colbase + 32 * bj) = w; } }
        if (kind == 3) {
            const int bb = u.pm >> 3, blk = u.pm & 7, h = (pn - 9) * 4 + wc;
            float* dst = KS + ((size_t)((bb * 16 + h) * 8 + blk)) * 64 + 8 * fq;
#pragma unroll
            for (int bj = 0; bj < 2; ++bj)
#pragma unroll
                for (int n = 0; n < 2; ++n)
#pragma unroll
                    for (int i = 0; i < 4; ++i) { float v = ks[bj][n][i]; v += __shfl_xor(v, 1); v += __shfl_xor(v, 2); v += __shfl_xor(v, 4); v += __shfl_xor(v, 8);
                        if (fr == 0) atomicAdd(dst + 32 * bj + 4 * n + i, v); }
        }
        return false;
    }
};

struct EpiIn8 { EpiProj p; EpiGate8 g;
    __device__ __forceinline__ bool operator()(f32x4 (&acc)[2][2][4][2], const g8::Unit& u, int wr, int wc, int fr, int fq) const { return (u.pn >= NT_QKV) ? g(acc, u, wr, wc, fr, fq) : p(acc, u, wr, wc, fr, fq); }
};

__device__ __forceinline__ void load_q64(float (&q)[64], const bf16_t* p) {
#pragma unroll
    for (int c = 0; c < 8; ++c) { const u32x4 w = *(const GAS u32x4*)(p + 8 * c);
        q[8 * c + 0] = bf_lo(w.x); q[8 * c + 1] = bf_hi(w.x); q[8 * c + 2] = bf_lo(w.y); q[8 * c + 3] = bf_hi(w.y);
        q[8 * c + 4] = bf_lo(w.z); q[8 * c + 5] = bf_hi(w.z); q[8 * c + 6] = bf_lo(w.w); q[8 * c + 7] = bf_hi(w.w); }
}
__device__ __forceinline__ float dot_q64(const float (&q)[64], const bf16_t* p) {
    float s0 = 0.f, s1 = 0.f;
#pragma unroll
    for (int c = 0; c < 8; ++c) { const u32x4 w = *(const GAS u32x4*)(p + 8 * c);
        s0 += q[8 * c + 0] * bf_lo(w.x); s1 += q[8 * c + 1] * bf_hi(w.x); s0 += q[8 * c + 2] * bf_lo(w.y); s1 += q[8 * c + 3] * bf_hi(w.y);
        s0 += q[8 * c + 4] * bf_lo(w.z); s1 += q[8 * c + 5] * bf_hi(w.z); s0 += q[8 * c + 6] * bf_lo(w.w); s1 += q[8 * c + 7] * bf_hi(w.w); }
    return s0 + s1;
}
__device__ __forceinline__ void attn_naive(const Frame& F) {
    const bf16_t* P = (const bf16_t*)(F.ws + WS_PROJ); const float* KS = (const float*)(F.ws + WS_KSUM);
    bf16_t* OA = (bf16_t*)(F.ws + WS_XN); bf16_t* OB = OA + (size_t)NTOK * 1024;
    LAS float* pbuf = (LAS float*)(F.lds + F.wave * 4096);
    const int gw = F.vcu * NWAVES + F.wave, NGW = F.G * NWAVES, lane = F.lane;
    const int NTASK = 2 * NB * 16 * SEQ;
    for (int k = 0; k * NGW < NTASK; ++k) {
        const int base = k * NGW; const int idx = base + ((gw + 37 * k) % NGW);
        if (idx >= NTASK) continue;
        const int which = idx / (NB * 16 * SEQ); const int r = idx % (NB * 16 * SEQ);
        const int b = r / (16 * SEQ), h = (r / SEQ) % 16, s = r % SEQ;
        const size_t row = (size_t)b * SEQ + s;
        const float slope = __builtin_amdgcn_exp2f(-0.5f * (float)(h + 1)) * LOG2E;
        float q[64];
        if (which == 0) {
            const int kv = h >> 3;
            load_q64(q, P + row * INC + QA0 + h * 64);
            float lsum = 0.f;
#pragma unroll
            for (int c = 0; c < 2; ++c) { const int kpos = s - 127 + lane + 64 * c; float p = 0.f;
                if (kpos >= 0) { const float sc = dot_q64(q, P + ((size_t)b * SEQ + kpos) * INC + KA0 + kv * 64) - slope * (float)(s - kpos); p = __builtin_amdgcn_exp2f(sc); }
                pbuf[64 * c + lane] = p; lsum += p; }
            lsum = wave_sum(lsum) + __builtin_amdgcn_exp2f(F.sinks[h] * LOG2E);
            LDS_WAIT(); asm volatile("" ::: "memory");
            float o = 0.f;
            for (int j = 0; j < 128; ++j) { const int kpos = s - 127 + j; if (kpos < 0) continue;
                const float v = bf_lo((unsigned)P[((size_t)b * SEQ + kpos) * INC + VA0 + kv * 64 + lane]); o += pbuf[j] * v; }
            OA[row * 1024 + h * 64 + lane] = (bf16_t)f2bf(o / lsum);
            LDS_WAIT(); asm volatile("" ::: "memory");
        } else {
            const int t = s >> 8;
            load_q64(q, P + row * INC + QB0 + h * 64);
            float g = -INFINITY;
            if (lane < t) { const float* kr = KS + ((size_t)((b * 16 + h) * 8 + lane)) * 64; float a = 0.f;
#pragma unroll
                for (int d = 0; d < 64; ++d) a += q[d] * ld_agent_f(kr + d);
                g = a; }
            unsigned selmask;
            if (t <= 3) selmask = (1u << t) - 1u;
            else { int rank = 0;
#pragma unroll
                for (int i = 0; i < 7; ++i) { const float gi = __shfl(g, i); if (i < t && (gi > g || (gi == g && i < lane))) ++rank; }
                selmask = (unsigned)__ballot(lane < t && rank < 3); }
            float lsum = 0.f; int nslot = 0; int blk_of[4] = {0, 0, 0, 0};
            for (int j = 0; j <= t; ++j) {
                if (j < t && !((selmask >> j) & 1u)) continue;
#pragma unroll
                for (int c = 0; c < 4; ++c) { const int kpos = 256 * j + 64 * c + lane; float p = 0.f;
                    if (kpos <= s) { const float sc = dot_q64(q, P + ((size_t)b * SEQ + kpos) * INC + KB0 + h * 64) - slope * (float)(s - kpos); p = __builtin_amdgcn_exp2f(sc); }
                    pbuf[nslot * 256 + 64 * c + lane] = p; lsum += p; }
                if (nslot == 0) blk_of[0] = j; else if (nslot == 1) blk_of[1] = j; else if (nslot == 2) blk_of[2] = j; else blk_of[3] = j;
                ++nslot;
            }
            lsum = wave_sum(lsum);
            LDS_WAIT(); asm volatile("" ::: "memory");
            float o = 0.f;
            for (int sl = 0; sl < nslot; ++sl) { const int j = sl == 0 ? blk_of[0] : sl == 1 ? blk_of[1] : sl == 2 ? blk_of[2] : blk_of[3];
                for (int kk = 0; kk < 256; ++kk) { const int kpos = 256 * j + kk; if (kpos > s) break;
                    const float v = bf_lo((unsigned)P[((size_t)b * SEQ + kpos) * INC + VB0 + h * 64 + lane]); o += pbuf[sl * 256 + kk] * v; } }
            OB[row * 1024 + h * 64 + lane] = (bf16_t)f2bf(o / lsum);
            LDS_WAIT(); asm volatile("" ::: "memory");
        }
    }
}

namespace att {
typedef float f32x16 __attribute__((ext_vector_type(16)));
typedef short s16x4 __attribute__((ext_vector_type(4)));
typedef __bf16 bf16x2_t __attribute__((ext_vector_type(2)));
__device__ __forceinline__ unsigned cvtpk(float lo, float hi) { f32x2 v = {lo, hi}; bf16x2_t b = __builtin_convertvector(v, bf16x2_t); return __builtin_bit_cast(unsigned, b); }
__device__ __forceinline__ s16x4 vtr(const LAS char* p) { return __builtin_bit_cast(s16x4, __builtin_amdgcn_ds_read_tr16_b64_v4i16((LAS s16x4*)p)); }
__device__ __forceinline__ void tile_map(int wave, int lane, int& key, int& chunk) { chunk = lane & 7; key = 8 * wave + (((lane >> 3) + (lane & 7)) & 7); }
__device__ __forceinline__ int k_off(int key, int chunk) { return chunk * 1024 + key * 16; }
__device__ __forceinline__ int v_off(int key, int chunk) { return ((chunk >> 2) * 4 + (key >> 4)) * 1024 + (key & 15) * 64 + (chunk & 3) * 16; }

__device__ __forceinline__ void tile_qk(f32x16& p0, f32x16& p1, const LAS char* Kt, const bf16x8 (&qr)[4], float base_l, float ch, int lane) {
    const int r32 = lane & 31, hi = lane >> 5;
#pragma unroll
    for (int r = 0; r < 16; ++r) { p0[r] = base_l + ch * (float)((r & 3) + 8 * (r >> 2)); p1[r] = p0[r] + 32.f * ch; }
    const LAS char* kp = Kt + hi * 1024 + r32 * 16;
    bf16x8 kf[8];
#pragma unroll
    for (int d0 = 0; d0 < 4; ++d0) { kf[2 * d0] = *(const LAS bf16x8*)(kp + d0 * 2048); kf[2 * d0 + 1] = *(const LAS bf16x8*)(kp + d0 * 2048 + 512); }
    __builtin_amdgcn_s_setprio(1);
#pragma unroll
    for (int d0 = 0; d0 < 4; ++d0) {
        p0 = __builtin_amdgcn_mfma_f32_32x32x16_bf16(kf[2 * d0], qr[d0], p0, 0, 0, 0);
        p1 = __builtin_amdgcn_mfma_f32_32x32x16_bf16(kf[2 * d0 + 1], qr[d0], p1, 0, 0, 0);
    }
    __builtin_amdgcn_s_setprio(0);
}
template <int MODE>
__device__ __forceinline__ void tile_sm(f32x16& p0, f32x16& p1, u32x4 (&pw)[4], float& lsum, int qrel, int lane) {
    const int hi = lane >> 5;
    if (MODE != 0) {
#pragma unroll
        for (int r = 0; r < 16; ++r) { const int kk = (r & 3) + 8 * (r >> 2) + 4 * hi; const int d0_ = qrel - kk, d1_ = d0_ - 32;
            const bool ok0 = MODE == 1 ? (d0_ >= 0) : (d0_ >= 0 && d0_ < 128), ok1 = MODE == 1 ? (d1_ >= 0) : (d1_ >= 0 && d1_ < 128);
            p0[r] = ok0 ? p0[r] : -INFINITY; p1[r] = ok1 ? p1[r] : -INFINITY; }
    }
    float s = 0.f;
#pragma unroll
    for (int r = 0; r < 16; ++r) { p0[r] = __builtin_amdgcn_exp2f(p0[r]); p1[r] = __builtin_amdgcn_exp2f(p1[r]); s += p0[r] + p1[r]; }
    lsum += s;
#pragma unroll
    for (int i = 0; i < 4; ++i) { pw[0][i] = cvtpk(p0[2 * i], p0[2 * i + 1]); pw[1][i] = cvtpk(p0[8 + 2 * i], p0[8 + 2 * i + 1]); pw[2][i] = cvtpk(p1[2 * i], p1[2 * i + 1]); pw[3][i] = cvtpk(p1[8 + 2 * i], p1[8 + 2 * i + 1]); }
}
__device__ __forceinline__ void tile_pv(f32x16 (&ot)[2], const LAS char* Vt, const u32x4 (&pw)[4], int lane) {
    const int hi = lane >> 5;
    const LAS char* vp = Vt + ((lane >> 4) & 1) * 32 + (lane & 3) * 8 + (4 * hi + ((lane & 15) >> 2)) * 64;
#pragma unroll
    for (int dh = 0; dh < 2; ++dh) {
        bf16x8 vf[4];
#pragma unroll
        for (int ks = 0; ks < 4; ++ks) { const s16x4 lo = vtr(vp + dh * 4096 + ks * 1024), hh = vtr(vp + dh * 4096 + ks * 1024 + 512);
            vf[ks] = (bf16x8){lo[0], lo[1], lo[2], lo[3], hh[0], hh[1], hh[2], hh[3]}; }
        __builtin_amdgcn_s_setprio(1);
#pragma unroll
        for (int ks = 0; ks < 4; ++ks) ot[dh] = __builtin_amdgcn_mfma_f32_32x32x16_bf16(vf[ks], __builtin_bit_cast(bf16x8, pw[ks]), ot[dh], 0, 0, 0);
        __builtin_amdgcn_s_setprio(0);
    }
}
template <int MODE>
__device__ __forceinline__ void tile_step(const LAS char* Kt, const LAS char* Vt, const bf16x8 (&qr)[4], f32x16 (&ot)[2], float& lsum, float base_l, float ch, int qrel, int lane) {
    f32x16 p0, p1; u32x4 pw[4];
    tile_qk(p0, p1, Kt, qr, base_l, ch, lane);
    tile_sm<MODE>(p0, p1, pw, lsum, qrel, lane);
    tile_pv(ot, Vt, pw, lane);
}
__device__ __forceinline__ void store_o(bf16_t* orow, const f32x16 (&ot)[2], float inv, int hi) {
#pragma unroll
    for (int dh = 0; dh < 2; ++dh)
#pragma unroll
        for (int g = 0; g < 4; ++g) { u32x2 w; w.x = pk2(ot[dh][4 * g] * inv, ot[dh][4 * g + 1] * inv); w.y = pk2(ot[dh][4 * g + 2] * inv, ot[dh][4 * g + 3] * inv);
            *(GAS u32x2*)(orow + 32 * dh + 8 * g + 4 * hi) = w; }
}
__device__ __forceinline__ void load_q(bf16x8 (&qr)[4], const bf16_t* qrow, int hi) {
#pragma unroll
    for (int d0 = 0; d0 < 4; ++d0) qr[d0] = *(const GAS bf16x8*)(qrow + 16 * d0 + 8 * hi);
}

__device__ __forceinline__ void swa_unit(const Frame& F, LAS char* L, int b, int n, int kv, int gh) {
    const bf16_t* P = (const bf16_t*)(F.ws + WS_PROJ); bf16_t* OA = (bf16_t*)(F.ws + WS_XN);
    const int lane = F.lane, w = F.wave, r32 = lane & 31, hi = lane >> 5;
    int key, chunk; tile_map(w, lane, key, chunk);
    const int wb = 128 * n - 128;
    u32x4 kr[4], vr[4];
#pragma unroll
    for (int i = 0; i < 4; ++i) if (n > 0 || i >= 2) { const bf16_t* src = P + ((size_t)b * SEQ + wb + 64 * i + key) * INC + kv * 64 + chunk * 8;
        kr[i] = *(const GAS u32x4*)(src + KA0); vr[i] = *(const GAS u32x4*)(src + VA0); }
#pragma unroll
    for (int i = 0; i < 4; ++i) if (n > 0 || i >= 2) { *(LAS u32x4*)(L + i * 8192 + k_off(key, chunk)) = kr[i]; *(LAS u32x4*)(L + 32768 + i * 8192 + v_off(key, chunk)) = vr[i]; }
    LDS_WAIT(); __syncthreads();
    const int hq = kv * 8 + gh * 4 + (w >> 1);
    const float ch = __builtin_amdgcn_exp2f(-0.5f * (float)(hq + 1)) * LOG2E;
    const float sink = __builtin_amdgcn_exp2f(F.sinks[hq] * LOG2E);
#pragma unroll 1
    for (int sub = 0; sub < 2; ++sub) {
        const int q0w = 64 * (w & 1) + 32 * sub, qw = 128 + q0w + r32;
        const size_t row = (size_t)b * SEQ + 128 * n + q0w + r32;
        bf16x8 qr[4]; load_q(qr, P + row * INC + QA0 + hq * 64, hi);
        f32x16 ot[2]; float lsum = 0.f;
#pragma unroll
        for (int r = 0; r < 16; ++r) { ot[0][r] = 0.f; ot[1][r] = 0.f; }
        const int i0 = q0w >> 6;
#pragma unroll 1
        for (int i = i0; i < i0 + 3; ++i) { if (n == 0 && i < 2) continue;
            tile_step<2>(L + i * 8192, L + 32768 + i * 8192, qr, ot, lsum, ch * (float)(64 * i - qw + 4 * hi), ch, qw - 64 * i, lane); }
        lsum += __shfl_xor(lsum, 32); lsum += sink;
        store_o(OA + row * 1024 + hq * 64, ot, 1.0f / lsum, hi);
    }
    __syncthreads();
}
__device__ __forceinline__ void moba_unit(const Frame& F, LAS char* L, int b, int h, int t) {
    const bf16_t* P = (const bf16_t*)(F.ws + WS_PROJ); const float* KS = (const float*)(F.ws + WS_KSUM); bf16_t* OB = (bf16_t*)(F.ws + WS_XN) + (size_t)NTOK * 1024;
    const int lane = F.lane, w = F.wave, r32 = lane & 31, hi = lane >> 5;
    int key, chunk; tile_map(w, lane, key, chunk);
    const int qpos = 256 * t + 32 * w + r32;
    const size_t row = (size_t)b * SEQ + qpos;
    bf16x8 qr[4]; load_q(qr, P + row * INC + QB0 + h * 64, hi);
    const float ch = __builtin_amdgcn_exp2f(-0.5f * (float)(h + 1)) * LOG2E;
    unsigned selmask = (1u << t) - 1u;
    if (t > 3) {
        float g[7];
#pragma unroll
        for (int j = 0; j < 7; ++j) { float a = 0.f;
            if (j < t) { const float* kr = KS + ((size_t)((b * 16 + h) * 8 + j)) * 64 + 8 * hi;
#pragma unroll
                for (int d0 = 0; d0 < 4; ++d0) { const f32x4 k0 = *(const GAS f32x4*)(kr + 16 * d0), k1 = *(const GAS f32x4*)(kr + 16 * d0 + 4); const u32x4 qw = __builtin_bit_cast(u32x4, qr[d0]);
                    a += bf_lo(qw.x) * k0[0] + bf_hi(qw.x) * k0[1] + bf_lo(qw.y) * k0[2] + bf_hi(qw.y) * k0[3] + bf_lo(qw.z) * k1[0] + bf_hi(qw.z) * k1[1] + bf_lo(qw.w) * k1[2] + bf_hi(qw.w) * k1[3]; }
                a += __shfl_xor(a, 32); }
            g[j] = (j < t) ? a : -INFINITY; }
        selmask = 0u;
#pragma unroll
        for (int j = 0; j < 7; ++j) { int rank = 0;
#pragma unroll
            for (int i = 0; i < 7; ++i) if (i != j) rank += (g[i] > g[j] || (g[i] == g[j] && i < j)) ? 1 : 0;
            if (j < t && rank < 3) selmask |= 1u << j; }
    }
    f32x16 ot[2]; float lsum = 0.f;
#pragma unroll
    for (int r = 0; r < 16; ++r) { ot[0][r] = 0.f; ot[1][r] = 0.f; }
    const int NS = 2 * (t + 1);
    const bf16_t* src0 = P + ((size_t)b * SEQ + key) * INC + h * 64 + chunk * 8;
    const int ko = k_off(key, chunk), vo = v_off(key, chunk);
#define MOBA_LOAD(R, step) do { const bf16_t* _s = src0 + (size_t)(128 * (step)) * INC; R[0] = *(const GAS u32x4*)(_s + KB0); R[1] = *(const GAS u32x4*)(_s + (size_t)64 * INC + KB0); \
        R[2] = *(const GAS u32x4*)(_s + VB0); R[3] = *(const GAS u32x4*)(_s + (size_t)64 * INC + VB0); } while (0)
#define MOBA_STEP(R, it) do { LAS char* B0 = L + ((it) & 1) * 32768; \
        *(LAS u32x4*)(B0 + ko) = R[0]; *(LAS u32x4*)(B0 + 8192 + ko) = R[1]; *(LAS u32x4*)(B0 + 16384 + vo) = R[2]; *(LAS u32x4*)(B0 + 24576 + vo) = R[3]; \
        LDS_WAIT(); asm volatile("" ::: "memory"); __builtin_amdgcn_s_barrier(); asm volatile("" ::: "memory");     \
        if ((it) + 2 < NS) MOBA_LOAD(R, (it) + 2); \
        const int j = (it) >> 1, tb = 128 * (it); \
        const bool past = j < t; const bool sel = past ? ((selmask >> j) & 1u) != 0u : true; \
        const int dg = past ? 99 : (w >> 1); \
        _Pragma("unroll 1") for (int c = 0; c < 2; ++c) { \
            const int tc = ((it) & 1) * 2 + c, tbc = tb + 64 * c; \
            const float bl = sel ? ch * (float)(tbc - qpos + 4 * hi) : -1e30f; \
            if (tc < dg) tile_step<0>(B0 + c * 8192, B0 + 16384 + c * 8192, qr, ot, lsum, bl, ch, 0, lane); \
            else if (tc == dg) tile_step<1>(B0 + c * 8192, B0 + 16384 + c * 8192, qr, ot, lsum, bl, ch, qpos - tbc, lane); } } while (0)
    u32x4 Ra[4], Rb[4];
    MOBA_LOAD(Ra, 0); MOBA_LOAD(Rb, 1);
#pragma unroll 1
    for (int it = 0; it < NS; it += 2) { MOBA_STEP(Ra, it); MOBA_STEP(Rb, it + 1); }
#undef MOBA_LOAD
#undef MOBA_STEP
    lsum += __shfl_xor(lsum, 32);
    store_o(OB + row * 1024 + h * 64, ot, 1.0f / lsum, hi);
    __syncthreads();
}
__device__ __forceinline__ void attn_phase(const Frame& F) {
    LAS char* L = (LAS char*)F.lds;
    { const int v = F.vcu; swa_unit(F, L, v >> 6, (v >> 2) & 15, (v >> 1) & 1, v & 1); }
    { const int bh = F.vcu >> 2, pr = F.vcu & 3; moba_unit(F, L, bh >> 4, bh & 15, 7 - pr); moba_unit(F, L, bh >> 4, bh & 15, pr); }
}
}

struct SchedUp {
    const char* A; const char* Bt; int G, c;
    __device__ __forceinline__ bool next(int i, g8::Unit& u) const {
        if (i >= 2) return false; int pm, pn; if (!g8::tile_order(32, 8, G, c, 0, pm, pn)) return false;
        u.a = A + ((size_t)i * NTOK + (size_t)pm * 256) * 1024 * 2; u.b = Bt + ((size_t)i * DM + (size_t)pn * 256) * 1024 * 2; u.rows = nullptr; u.nkt = 16; u.pm = pm; u.pn = pn; u.x0 = i; u.x1 = 0; return true;
    }
};
struct EpiUp {
    const bf16_t* P; bf16_t* MG;
    __device__ __forceinline__ bool operator()(f32x4 (&acc)[2][2][4][2], const g8::Unit& u, int wr, int wc, int fr, int fq) const {
        const int col = u.pn * 256 + wc * 64 + 8 * fq; const int gofs = (u.x0 == 0) ? GA0 : GB0;
#pragma unroll
        for (int ai = 0; ai < 2; ++ai) {
            u32x4 gv[4][2];
#pragma unroll
            for (int m = 0; m < 4; ++m)
#pragma unroll
                for (int bj = 0; bj < 2; ++bj) gv[m][bj] = NT_LDU4(P + (size_t)(u.pm * 256 + ai * 128 + wr * 64 + m * 16 + fr) * INC + gofs + col + 32 * bj);
#pragma unroll
            for (int m = 0; m < 4; ++m) { const int row = u.pm * 256 + ai * 128 + wr * 64 + m * 16 + fr;
#pragma unroll
                for (int bj = 0; bj < 2; ++bj) {
                    const u32x4 g = gv[m][bj];
                    const float b0 = bf_lo(g.x), b1 = bf_hi(g.x), b2 = bf_lo(g.y), b3 = bf_hi(g.y), b4 = bf_lo(g.z), b5 = bf_hi(g.z), b6 = bf_lo(g.w), b7 = bf_hi(g.w);
                    f32x4& v0 = acc[ai][bj][m][0]; f32x4& v1 = acc[ai][bj][m][1];
                    if (u.x0 == 0) {
                        v0[0] *= b0; v0[1] *= b1; v0[2] *= b2; v0[3] *= b3; v1[0] *= b4; v1[1] *= b5; v1[2] *= b6; v1[3] *= b7;
                    } else {
                        u32x4 w; w.x = pk2(v0[0] * b0, v0[1] * b1); w.y = pk2(v0[2] * b2, v0[3] * b3); w.z = pk2(v1[0] * b4, v1[1] * b5); w.w = pk2(v1[2] * b6, v1[3] * b7);
                        *(GAS u32x4*)(MG + (size_t)row * DM + col + 32 * bj) = w;
                    } } }
        }
        return u.x0 == 0;
    }
};

struct EpiOut {
    const float* X; bf16_t* X1B; float* SS; unsigned char* X8;
    __device__ __forceinline__ bool operator()(f32x4 (&acc)[2][2][4][2], const g8::Unit& u, int wr, int wc, int fr, int fq) const {
        const int col = u.pn * 256 + wc * 64 + 8 * fq;
#pragma unroll
        for (int ai = 0; ai < 2; ++ai) {
            f32x4 xa[4][2], xb[4][2];
#pragma unroll
            for (int m = 0; m < 4; ++m)
#pragma unroll
                for (int bj = 0; bj < 2; ++bj) { const size_t off = (size_t)(u.pm * 256 + ai * 128 + wr * 64 + m * 16 + fr) * DM + col + 32 * bj; xa[m][bj] = NT_LD4(X + off); xb[m][bj] = NT_LD4(X + off + 4); }
#pragma unroll
            for (int m = 0; m < 4; ++m) { const int row = u.pm * 256 + ai * 128 + wr * 64 + m * 16 + fr; float s = 0.f;
#pragma unroll
                for (int bj = 0; bj < 2; ++bj) { const size_t off = (size_t)row * DM + col + 32 * bj;
                    const f32x4 a = xa[m][bj] + acc[ai][bj][m][0], b = xb[m][bj] + acc[ai][bj][m][1];
                    s += (a[0] * a[0] + a[1] * a[1]) + (a[2] * a[2] + a[3] * a[3]) + (b[0] * b[0] + b[1] * b[1]) + (b[2] * b[2] + b[3] * b[3]);
                    u32x4 w; w.x = pk2(a[0], a[1]); w.y = pk2(a[2], a[3]); w.z = pk2(b[0], b[1]); w.w = pk2(b[2], b[3]);
                    *(GAS u32x4*)(X1B + off) = w;
                    u32x2 w8; w8.x = pk8(a[0] * SX8, a[1] * SX8, a[2] * SX8, a[3] * SX8); w8.y = pk8(b[0] * SX8, b[1] * SX8, b[2] * SX8, b[3] * SX8); *(GAS u32x2*)(X8 + off) = w8; }
                s += __shfl_xor(s, 16); s += __shfl_xor(s, 32);
                if (fq == 0) SS[(size_t)row * 32 + u.pn * 4 + wc] = s; }
        }
        return false;
    }
};

__device__ __forceinline__ void p5a_route(const Frame& F) {
    typedef float f32x16 __attribute__((ext_vector_type(16)));
    const bf16_t* X1B = (const bf16_t*)(F.ws + WS_XN); const float* SS = (const float*)(F.ws + WS_SS); const bf16_t* GWT = (const bf16_t*)(F.ws + WS_GWT);
    unsigned* TOS = (unsigned*)(F.ws + WS_SL + SL_TOS); float* WOS = (float*)(F.ws + WS_SL + SL_WOS); float* RSOS = (float*)(F.ws + WS_SL + SL_RSOS);
    unsigned* ECNT = (unsigned*)(F.ws + WS_CTL) + CW_ECNT; unsigned* BCNT = (unsigned*)(F.ws + WS_CTL) + CW_BCNT;
    unsigned* BTOK = (unsigned*)(F.ws + WS_BK + BK_TOK); unsigned* BRA = (unsigned*)(F.ws + WS_BK + BK_RA); unsigned* BRB = (unsigned*)(F.ws + WS_BK + BK_RB);
    LAS unsigned* le = (LAS unsigned*)(F.lds + LDS_X_OFF);
    LAS float* lw = (LAS float*)(le + 64); LAS float* lr = lw + 64; LAS unsigned* lb = (LAS unsigned*)(lr + 32);
    LAS unsigned* lk = lb + 16; LAS unsigned* lkb = lk + 32; LAS unsigned* lsl = lkb + 32;
    LAS float* PT = (LAS float*)F.lds;
    const int lane = F.lane, w = F.wave, r32 = lane & 31, hi = lane >> 5, tokb = F.vcu * 32;
    f32x16 acc;
#pragma unroll
    for (int r = 0; r < 16; ++r) acc[r] = 0.f;
    const bf16_t* xa = X1B + (size_t)(tokb + r32) * DM + 256 * w + 8 * hi; const bf16_t* gb = GWT + (size_t)r32 * DM + 256 * w + 8 * hi;
#pragma unroll 1
    for (int hb = 0; hb < 2; ++hb) {
        bf16x8 af[8], bfr[8];
#pragma unroll
        for (int i = 0; i < 8; ++i) { af[i] = *(const GAS bf16x8*)(xa + 128 * hb + 16 * i); bfr[i] = *(const GAS bf16x8*)(gb + 128 * hb + 16 * i); }
#pragma unroll
        for (int i = 0; i < 8; ++i) acc = __builtin_amdgcn_mfma_f32_32x32x16_bf16(af[i], bfr[i], acc, 0, 0, 0);
    }
#pragma unroll
    for (int r = 0; r < 16; ++r) PT[(w * 32 + ((r & 3) + 8 * (r >> 2) + 4 * hi)) * 32 + r32] = acc[r];
    LDS_WAIT(); __syncthreads();
    LAS float* LG = PT + 8192;
#pragma unroll
    for (int i = 0; i < 2; ++i) { const int o = F.tid + 512 * i; float v = 0.f;
#pragma unroll
        for (int ww = 0; ww < 8; ++ww) v += PT[ww * 1024 + o];
        LG[o] = v; }
    LDS_WAIT(); __syncthreads();
    if (F.tid < 32) {
        const int lt = F.tid, tok = tokb + lt; float ss = 0.f;
#pragma unroll
        for (int j = 0; j < 8; ++j) { const f32x4 p = ((const GAS f32x4*)(SS + (size_t)tok * 32))[j]; ss += (p.x + p.y) + (p.z + p.w); }
        const float rstd = 1.0f / sqrtf(ss * (1.f / DM) + EPS);
        float lgp[4], el[4];
#pragma unroll
        for (int c = 0; c < 4; ++c) lgp[c] = LG[lt * 32 + c] * rstd;
        int gi = 0; float gm = lgp[0];
#pragma unroll
        for (int c = 1; c < 4; ++c) if (lgp[c] > gm) { gm = lgp[c]; gi = c; }
        float gden = 0.f;
#pragma unroll
        for (int c = 0; c < 4; ++c) gden += __expf(lgp[c] - gm);
        const float g_p = 1.0f / gden;
#pragma unroll
        for (int c = 0; c < 4; ++c) el[c] = LG[lt * 32 + 4 + 4 * gi + c] * rstd;
        int e1 = 0; float m1 = el[0];
#pragma unroll
        for (int c = 1; c < 4; ++c) if (el[c] > m1) { m1 = el[c]; e1 = c; }
        int e2 = -1; float m2 = -INFINITY;
#pragma unroll
        for (int c = 0; c < 4; ++c) if (c != e1 && el[c] > m2) { m2 = el[c]; e2 = c; }
        const float w1 = g_p / (1.0f + __expf(m2 - m1)), w2 = g_p / (1.0f + __expf(m1 - m2));
        le[2 * lt] = (unsigned)(gi * 4 + e1); le[2 * lt + 1] = (unsigned)(gi * 4 + e2); lw[2 * lt] = w1; lw[2 * lt + 1] = w2; lr[lt] = rstd;
        const int ea = e1 < e2 ? e1 : e2, eb = e1 < e2 ? e2 : e1;
        lk[lt] = (unsigned)(gi * 6 + ((ea * (7 - ea)) >> 1) + (eb - ea - 1)) | (e1 > e2 ? 64u : 0u);
    }
    LDS_WAIT(); __syncthreads();
    if (F.tid < NEXP) { unsigned c = 0; for (int i = 0; i < 64; ++i) c += (le[i] == (unsigned)F.tid) ? 1u : 0u; lb[F.tid] = c ? __hip_atomic_fetch_add(ECNT + F.tid, c, RLX_AGENT) : 0u; }
    else if (F.tid >= 64 && F.tid < 64 + NBK) { const unsigned b = (unsigned)(F.tid - 64); unsigned c = 0; for (int i = 0; i < 32; ++i) c += ((lk[i] & 63u) == b) ? 1u : 0u; lkb[b] = c ? __hip_atomic_fetch_add(BCNT + b, c, RLX_AGENT) : 0u; }
    LDS_WAIT(); __syncthreads();
    if (F.tid < 64) { const int a = F.tid; const unsigned e = le[a]; unsigned rank = 0;
        for (int i = 0; i < a; ++i) rank += (le[i] == e) ? 1u : 0u;
        const unsigned slot = e * ECAP + lb[e] + rank; const int tok = F.vcu * 32 + (a >> 1);
        TOS[slot] = (unsigned)tok; WOS[slot] = lw[a]; RSOS[slot] = lr[a >> 1]; lsl[a] = slot; }
    LDS_WAIT(); __syncthreads();
    if (F.tid < 32) { const int lt = F.tid; const unsigned kk = lk[lt], b = kk & 63u, sw = kk >> 6; unsigned rank = 0;
        for (int i = 0; i < lt; ++i) rank += ((lk[i] & 63u) == b) ? 1u : 0u;
        const unsigned bs = b * BCAP + lkb[b] + rank;
        BTOK[bs] = (unsigned)(tokb + lt); BRA[bs] = lsl[2 * lt + (int)sw]; BRB[bs] = lsl[2 * lt + 1 - (int)sw]; }
    __syncthreads();
}
struct MoeInfo { unsigned mt0[NEXP + 1]; };
__device__ __forceinline__ int moe_expert_of(const LAS unsigned* mt0, int mtile) { int e = 0;
#pragma unroll
    for (int q = 1; q < NEXP; ++q) if ((unsigned)mtile >= mt0[q]) e = q; return e; }
struct SchedMoeUp {
    const char* H2; const char* Wgu; const int* TOS; const LAS unsigned* mt0; int G, c;
    __device__ __forceinline__ bool next(int i, g8::Unit& u) const {
        const int L = i * G + c; const int nun = (int)mt0[NEXP] * 4; if (L >= nun) return false;
        const int mtile = L >> 2, nt = L & 3, e = moe_expert_of(mt0, mtile), sb = e * ECAP + (mtile - (int)mt0[e]) * 256;
        u.a = H2; u.rows = TOS + sb; u.b = Wgu + ((size_t)e * 1024 + (size_t)nt * 256) * DM; u.nkt = DM / 128; u.pm = mtile; u.pn = nt; u.x0 = e; u.x1 = sb; return true;
    }
};
struct EpiMoeUp {
    const float* WOS; const float* RSOS; bf16_t* HID;
    __device__ __forceinline__ bool operator()(f32x4 (&acc)[2][2][4][2], const g8::Unit& u, int wr, int wc, int fr, int fq) const {
        const int col = u.pn * 128 + wc * 32 + 8 * fq;
        float wv[2][4], rv[2][4];
#pragma unroll
        for (int ai = 0; ai < 2; ++ai)
#pragma unroll
            for (int m = 0; m < 4; ++m) { const int slot = u.x1 + ai * 128 + wr * 64 + m * 16 + fr; wv[ai][m] = WOS[slot]; rv[ai][m] = RSOS[slot] * (1.0f / (SX8 * SW8)); }
#pragma unroll
        for (int ai = 0; ai < 2; ++ai)
#pragma unroll
            for (int m = 0; m < 4; ++m) { const int slot = u.x1 + ai * 128 + wr * 64 + m * 16 + fr; const float w = wv[ai][m], rs = rv[ai][m];
                float hv[8];
#pragma unroll
                for (int n = 0; n < 2; ++n)
#pragma unroll
                    for (int i = 0; i < 4; ++i) { const float g = acc[ai][0][m][n][i] * rs, up = acc[ai][1][m][n][i] * rs;
                        hv[4 * n + i] = g * __builtin_amdgcn_rcpf(1.0f + __builtin_amdgcn_exp2f(-g * LOG2E)) * up * w; }
#pragma unroll
                for (int q = 0; q < 8; ++q) hv[q] = fminf(fmaxf(hv[q] * SH8, -448.f), 448.f);
                u32x2 o; o.x = pk8(hv[0], hv[1], hv[2], hv[3]); o.y = pk8(hv[4], hv[5], hv[6], hv[7]);
                *(GAS u32x2*)((unsigned char*)HID + (size_t)slot * DEXP + col) = o; }
        return false;
    }
};
__device__ __forceinline__ int moe_bucket_of(const LAS unsigned* bt0, int mtile) { int b = 0;
#pragma unroll
    for (int q = 1; q < NBK; ++q) if ((unsigned)mtile >= bt0[q]) b = q; return b; }
struct SchedMoeDown {
    const char* HID; const char* Wd; const int* BRA; const int* BRB; const LAS unsigned* bt0; int G, c;
    __device__ __forceinline__ bool next(int i, g8::Unit& u) const {
        const int h = i & 1, L = (i >> 1) * G + c; const int nun = (int)bt0[NBK] * 8; if (L >= nun) return false;
        const int mtile = L >> 3, pn = L & 7, b = moe_bucket_of(bt0, mtile), lt = mtile - (int)bt0[b], sb = b * BCAP + lt * 256;
        const int g = b / 6, p = b - g * 6, e = g * 4 + (int)(((h ? 0xFB9u : 0x940u) >> (2 * p)) & 3u);
        int lim = (int)bt0[64 + b] - lt * 256; lim = lim > 256 ? 256 : lim;
        u.a = HID; u.rows = (h ? BRB : BRA) + sb; u.b = Wd + ((size_t)e * DM + (size_t)pn * 256) * DEXP; u.nkt = DEXP / 128; u.pm = mtile; u.pn = pn; u.x0 = h | (lim << 1); u.x1 = sb; return true;
    }
};
struct EpiMoeDown {
    float* out; const bf16_t* X1B; const unsigned* BTOK;
    __device__ __forceinline__ bool operator()(f32x4 (&acc)[2][2][4][2], const g8::Unit& u, int wr, int wc, int fr, int fq) const {
        if ((u.x0 & 1) == 0) return true;
        const int lim = u.x0 >> 1, col = u.pn * 256 + wc * 64 + 8 * fq; constexpr float isc = 1.0f / (SH8 * SD8);
#pragma unroll
        for (int ai = 0; ai < 2; ++ai) {
            unsigned tk[4]; u32x4 xv[4][2];
#pragma unroll
            for (int m = 0; m < 4; ++m) { const int r = ai * 128 + wr * 64 + m * 16 + fr; tk[m] = BTOK[u.x1 + r]; }
#pragma unroll
            for (int m = 0; m < 4; ++m)
#pragma unroll
                for (int bj = 0; bj < 2; ++bj) xv[m][bj] = NT_LDU4(X1B + (size_t)tk[m] * DM + col + 32 * bj);
#pragma unroll
            for (int m = 0; m < 4; ++m) { const int r = ai * 128 + wr * 64 + m * 16 + fr;
                if (r < lim) {
#pragma unroll
                    for (int bj = 0; bj < 2; ++bj) { const u32x4 x = xv[m][bj]; const f32x4 a = acc[ai][bj][m][0], b = acc[ai][bj][m][1];
                        f32x4 o0, o1; o0[0] = bf_lo(x.x) + a[0] * isc; o0[1] = bf_hi(x.x) + a[1] * isc; o0[2] = bf_lo(x.y) + a[2] * isc; o0[3] = bf_hi(x.y) + a[3] * isc;
                        o1[0] = bf_lo(x.z) + b[0] * isc; o1[1] = bf_hi(x.z) + b[1] * isc; o1[2] = bf_lo(x.w) + b[2] * isc; o1[3] = bf_hi(x.w) + b[3] * isc;
                        GAS f32x4* op = (GAS f32x4*)(out + (size_t)tk[m] * DM + col + 32 * bj); __builtin_nontemporal_store(o0, op); __builtin_nontemporal_store(o1, op + 1); } } }
        }
        return false;
    }
};
__device__ __forceinline__ void moe_load_buckets(const Frame& F, LAS unsigned* bt0) {
    const unsigned* BCNT = (const unsigned*)(F.ws + WS_CTL) + CW_BCNT;
    if (F.tid < NBK) { const unsigned c = ld_agent(BCNT + F.tid); bt0[64 + F.tid] = c; bt0[32 + F.tid] = (c + 255u) >> 8; }
    LDS_WAIT(); __syncthreads();
    if (F.tid == 0) { unsigned s = 0; for (int b = 0; b < NBK; ++b) { bt0[b] = s; s += bt0[32 + b]; } bt0[NBK] = s; }
    LDS_WAIT(); __syncthreads();
}
__device__ __forceinline__ void moe_load_info(const Frame& F, LAS unsigned* mt0) {
    const unsigned* ECNT = (const unsigned*)(F.ws + WS_CTL) + CW_ECNT;
    if (F.tid < NEXP) mt0[32 + F.tid] = (ld_agent(ECNT + F.tid) + 255u) >> 8;
    LDS_WAIT(); __syncthreads();
    if (F.tid == 0) { unsigned s = 0; for (int e = 0; e < NEXP; ++e) { mt0[e] = s; s += mt0[32 + e]; } mt0[NEXP] = s; }
    LDS_WAIT(); __syncthreads();
}

constexpr int N_PHASES = 9;
__global__ void __launch_bounds__(NWAVES * 64, 2) fwd(Args args) {
    extern __shared__ __attribute__((aligned(16))) unsigned char lds[];
    Frame F;
    F.lds = (LAS unsigned char*)lds;
    F.tid = threadIdx.x; F.lane = F.tid & 63; F.wave = __builtin_amdgcn_readfirstlane(F.tid >> 6);
    F.G = gridDim.x; { const int bx = blockIdx.x; F.vcu = (F.G % 8 == 0) ? (bx % 8) * (F.G / 8) + bx / 8 : bx; }
    F.x = args.in[0]; F.g_mix = args.in[1]; F.w_in = args.in[2]; F.qn_a = args.in[3]; F.kn_a = args.in[4]; F.sinks = args.in[5]; F.qn_b = args.in[6]; F.kn_b = args.in[7];
    F.w_upa = args.in[8]; F.w_upb = args.in[9]; F.w_out = args.in[10]; F.g_ffn = args.in[11]; F.w_rg = args.in[12]; F.w_re = args.in[13]; F.w_ge = args.in[14]; F.w_ue = args.in[15]; F.w_de = args.in[16];
    F.out = args.out; F.ws = args.ws;
    volatile LAS unsigned* MISC = (volatile LAS unsigned*)(F.lds + MISC_OFF);
    for (int u = F.tid; u < (LDS_X_OFF - LDSCTL_OFF) / 4; u += NWAVES * 64) ((LAS unsigned*)(F.lds + LDSCTL_OFF))[u] = 0u;
    __syncthreads();
    gu32* ctl = (gu32*)(F.ws + WS_CTL);
    XcdBarrier bar; bar.bar = (unsigned*)(ctl + CW_BAR); bar.x = 0; bar.st = nullptr;
    const int lo = args.ph_lo, hi = args.ph_hi;
    const bool multi = (hi - lo) > 1;
    if (multi) bar = xcd_barrier_post((unsigned*)(ctl + CW_BAR), MISC + 8);
#define IN(k) (lo <= (k) && (k) < hi)
#define SEAM(k) do { if (IN(k) && IN((k) + 1)) xcd_barrier(bar); } while (0)
    const int cid = (int)blockIdx.x;

    if (IN(0)) { p0_prologue(F); SEAM(0); }
    if (IN(1)) {
        { SchedIn8 S{(const char*)(F.ws + WS_X8), (const char*)(F.ws + WS_WIN8), F.G, cid};
          const float* XS = (const float*)(F.ws + WS_XS); const float* WSC = (const float*)(F.ws + WS_WSC);
          EpiIn8 E{EpiProj{(bf16_t*)(F.ws + WS_PROJ), (float*)(F.ws + WS_KSUM), F.qn_a, F.kn_a, F.qn_b, F.kn_b, XS, WSC}, EpiGate8{(bf16_t*)(F.ws + WS_PROJ), XS, WSC}};
          g8::gemm_phase<EpiIn8, SchedIn8, false, false, true>(F.lds, DM / 2, DM / 2, S, E); }
        { constexpr int NUN = (NTOK / 256) * (INC / 256); const int r = NUN % F.G;
          if (r == 0) convert_moe_gate_up(F, cid, F.G); else if (cid >= r) convert_moe_gate_up(F, cid - r, F.G - r); }
        SEAM(1);
    }
    #if defined(ATTN_NAIVE)
    if (IN(2)) { attn_naive(F); SEAM(2); }
#else
    if (IN(2)) { att::attn_phase(F); SEAM(2); }
#endif
    if (IN(3)) {
        SchedUp S{(const char*)(F.ws + WS_XN), (const char*)(F.ws + WS_WUP), F.G, cid};
        EpiUp E{(const bf16_t*)(F.ws + WS_PROJ), (bf16_t*)(F.ws + WS_MERGED)};
        g8::gemm_phase<EpiUp, SchedUp, false>(F.lds, 1024, 1024, S, E);
        SEAM(3);
    }
    if (IN(4)) {
        SchedTiles S{(const char*)(F.ws + WS_MERGED), (const char*)(F.ws + WS_WOUT), NTOK / 256, DM / 256, DM, F.G, cid};
        EpiOut E{F.x, (bf16_t*)(F.ws + WS_XN), (float*)(F.ws + WS_SS), (unsigned char*)(F.ws + WS_X8)};
        g8::gemm_phase<EpiOut, SchedTiles, false>(F.lds, DM, DM, S, E);
        SEAM(4);
    }
    if (IN(5)) { p5a_route(F); if (IN(5) && IN(7)) xcd_barrier(bar); }
    LAS unsigned* mt0 = (LAS unsigned*)(F.lds + LDS_X_OFF + 1024);
    if (IN(7)) {
        moe_load_info(F, mt0);
        SchedMoeUp S{(const char*)(F.ws + WS_X8), (const char*)(F.ws + WS_WGU), (const int*)(F.ws + WS_SL + SL_TOS), mt0, F.G, F.vcu};
        EpiMoeUp E{(const float*)(F.ws + WS_SL + SL_WOS), (const float*)(F.ws + WS_SL + SL_RSOS), (bf16_t*)(F.ws + WS_PROJ)};
        g8::gemm_phase<EpiMoeUp, SchedMoeUp, true, true>(F.lds, DM / 2, DM / 2, S, E);
        { const int r = ((int)mt0[NEXP] * 4) % F.G;
          if (r == 0) convert_moe_down(F, F.vcu, F.G); else if (F.vcu >= r) convert_moe_down(F, F.vcu - r, F.G - r); }
        SEAM(7);
    }
    if (IN(8)) {
        LAS unsigned* bt0 = mt0 + 128;
        moe_load_buckets(F, bt0);
        SchedMoeDown S{(const char*)(F.ws + WS_PROJ), (const char*)(F.ws + WS_WD), (const int*)(F.ws + WS_BK + BK_RA), (const int*)(F.ws + WS_BK + BK_RB), bt0, F.G, F.vcu};
        EpiMoeDown E{F.out, (const bf16_t*)(F.ws + WS_XN), (const unsigned*)(F.ws + WS_BK + BK_TOK)};
        g8::gemm_phase<EpiMoeDown, SchedMoeDown, true, true>(F.lds, DEXP / 2, DEXP / 2, S, E);
    }
#undef IN
#undef SEAM
}

extern "C" void kernel_launch(void* const* d_in, const int* in_sizes, int n_in, void* d_out, int out_size, void* d_ws, size_t ws_size, hipStream_t stream) {
    static int grid = 0;
    if (grid == 0) {
        if (n_in != 17 || in_sizes[0] != NTOK * DM || out_size != NTOK * DM || ws_size < WS_END) {
            fprintf(stderr, "kernel_launch: unexpected problem (n_in %d, in0 %d, out %d, ws %zu)\n", n_in, n_in > 0 ? in_sizes[0] : -1, out_size, ws_size); grid = -1; return; }
        int dev = 0, cus = 0, per_cu = 0;
        if (hipGetDevice(&dev) != hipSuccess || hipDeviceGetAttribute(&cus, hipDeviceAttributeMultiprocessorCount, dev) != hipSuccess) { grid = -1; return; }
        if (hipFuncSetAttribute((const void*)fwd, hipFuncAttributeMaxDynamicSharedMemorySize, LDS_BYTES) != hipSuccess) { fprintf(stderr, "kernel_launch: hipFuncSetAttribute failed\n"); grid = -1; return; }
        if (hipOccupancyMaxActiveBlocksPerMultiprocessor(&per_cu, (const void*)fwd, NWAVES * 64, LDS_BYTES) != hipSuccess || per_cu < 1)
            fprintf(stderr, "kernel_launch: occupancy query reports %d workgroups per CU\n", per_cu);
        (void)hipGetLastError();
        grid = cus;
        if (grid != 256) fprintf(stderr, "kernel_launch: %d CUs (built for 256)\n", grid);
    }
    if (grid < 0) return;
    (void)hipMemsetAsync((char*)d_ws + WS_CTL, 0, CTL_ZERO_BYTES, stream);
    Args a{};
    for (int i = 0; i < 17; ++i) a.in[i] = (const float*)d_in[i];
    a.out = (float*)d_out; a.ws = (unsigned char*)d_ws;
#if MK_LAUNCHES == 1
    a.ph_lo = 0; a.ph_hi = N_PHASES;
    hipLaunchKernelGGL(fwd, dim3(grid), dim3(NWAVES * 64), LDS_BYTES, stream, a);
#else
#ifndef PROBE_REP_MASK
#define PROBE_REP_MASK 0
#endif
    for (int p = 0; p < N_PHASES; ++p) { if (p == 6) continue; a.ph_lo = p; a.ph_hi = p + 1;
        for (int rep = 0; rep < 1 + ((PROBE_REP_MASK >> p) & 1); ++rep) hipLaunchKernelGGL(fwd, dim3(grid), dim3(NWAVES * 64), LDS_BYTES, stream, a); }
#endif
}
```

```cpp
#include <hip/hip_runtime.h>
#include <cstdio>
#include <cstdint>

#ifndef MK_LAUNCHES
#define MK_LAUNCHES 1
#endif

#define LAS __attribute__((address_space(3)))
#define GAS __attribute__((address_space(1)))
typedef unsigned short bf16_t;
typedef short bf16x8 __attribute__((ext_vector_type(8)));
typedef float f32x4 __attribute__((ext_vector_type(4)));
typedef float f32x2 __attribute__((ext_vector_type(2)));
typedef unsigned u32x4 __attribute__((ext_vector_type(4)));
typedef unsigned u32x2 __attribute__((ext_vector_type(2)));
typedef GAS unsigned gu32;
#define RLX_AGENT __ATOMIC_RELAXED, __HIP_MEMORY_SCOPE_AGENT

constexpr int DM = 2048, NB = 4, SEQ = 2048, NTOK = NB * SEQ, HD = 64;
constexpr int INC = 8448;
constexpr int QA0 = 0, KA0 = 1024, VA0 = 1152, QB0 = 1280, KB0 = 2304, VB0 = 3328, GA0 = 4352, GB0 = 6400;
constexpr int NEXP = 16, DEXP = 512;
constexpr float EPS = 1e-6f;
constexpr float LOG2E = 1.4426950408889634f;
constexpr float QSCALE = 0.125f * LOG2E;
constexpr int SLOT_CAP = NTOK * 2 + NEXP * 256;

constexpr size_t MiB = 1u << 20;
constexpr size_t WS_CTL = 0, CTL_ZERO_BYTES = 64 * 1024;
constexpr size_t WS_KSUM = 1 * MiB;
constexpr size_t WS_XS = 1 * MiB + 512 * 1024;
constexpr size_t WS_WSC = 1 * MiB + 768 * 1024;
constexpr size_t WS_PM = 3 * MiB + 256 * 1024;
constexpr size_t WS_RS = 3 * MiB + 512 * 1024;
constexpr size_t WS_WOSC = 3 * MiB + 576 * 1024;
constexpr size_t WS_OCAT = 85 * MiB;
constexpr size_t WS_SS = 2 * MiB;
constexpr size_t WS_RT = 3 * MiB;
constexpr size_t RT_TOKE = 0, RT_TOKW = 64 * 1024, RT_CNT = 128 * 1024, RT_INFO = 160 * 1024, RT_TOS = 192 * 1024, RT_WOS = 320 * 1024, RT_SOT = 448 * 1024, RT_RSTD = 512 * 1024, RT_RSOS = 576 * 1024;
constexpr size_t WS_WIN = 4 * MiB;
constexpr size_t WS_WUP = 37 * MiB;
constexpr size_t WS_WOUT = 45 * MiB;
constexpr size_t WS_WGU = 53 * MiB;
constexpr size_t WS_WD = 117 * MiB;
constexpr size_t WS_XN = 149 * MiB;
constexpr size_t WS_PROJ = 181 * MiB;
constexpr size_t WS_MERGED = 4 * MiB;
constexpr size_t WS_SL = 313 * MiB;
constexpr size_t SL_TOS = 0, SL_WOS = 516 * 1024, SL_RSOS = 1032 * 1024, SL_T2S = 1548 * 1024;
constexpr size_t WS_Y2 = 4 * MiB;
constexpr int NBK = 24, BCAP = 8192;
constexpr int ECAP = 8192;
constexpr size_t WS_GWT = 3 * MiB;
constexpr size_t WS_X8 = 316 * MiB;
constexpr size_t WS_BK = 332 * MiB;
constexpr size_t BK_TOK = 0, BK_RA = 768 * 1024, BK_RB = 1536 * 1024, BK_BYTES = 2304 * 1024;
constexpr size_t WS_END = 335 * MiB;
constexpr float SO8 = 16.f, SWU8 = 32.f;
constexpr float SM8 = 32.f, SWO8 = 32.f;
constexpr float SX8 = 8.f, SW8 = 32.f, SH8 = 16.f, SD8 = 16.f, SXN8 = 8.f, SWI8 = 32.f, SY8 = 64.f;
constexpr int NT_QKV = GA0 / 256;
constexpr size_t WS_WIN8 = WS_WIN;

constexpr int CW_TMO = 0, CW_BAR = 1024, CW_ECNT = 6144, CW_BCNT = 6176, CW_PCNT = 6464;

constexpr int RING_BYTES = 131072;
constexpr int LDSCTL_OFF = RING_BYTES, MISC_OFF = LDSCTL_OFF + 320;
constexpr int LDS_X_OFF = RING_BYTES + 1024;
constexpr int LDS_BYTES = 147456;
constexpr int NWAVES = 8;

#define LDS_WAIT() asm volatile("s_waitcnt lgkmcnt(0)" ::: "memory")
#define VM_WAIT() asm volatile("s_waitcnt vmcnt(0)" ::: "memory")
__device__ __forceinline__ unsigned f2bf(float f) { unsigned u = __builtin_bit_cast(unsigned, f); return (u + 0x7fffu + ((u >> 16) & 1u)) >> 16; }
__device__ __forceinline__ unsigned pk2(float lo, float hi) { return f2bf(lo) | (f2bf(hi) << 16); }
__device__ __forceinline__ float bf_lo(unsigned w) { return __builtin_bit_cast(float, w << 16); }
__device__ __forceinline__ float bf_hi(unsigned w) { return __builtin_bit_cast(float, w & 0xffff0000u); }
__device__ __forceinline__ float wave_sum(float v) {
#pragma unroll
    for (int o = 1; o < 64; o <<= 1) v += __shfl_xor(v, o);
    return v;
}
typedef int i32x4 __attribute__((ext_vector_type(4)));
typedef int i32x8 __attribute__((ext_vector_type(8)));
__device__ __forceinline__ unsigned pk8(float a, float b, float c, float d) {
    int w = __builtin_amdgcn_cvt_pk_fp8_f32(a, b, 0, false); w = __builtin_amdgcn_cvt_pk_fp8_f32(c, d, w, true); return (unsigned)w; }
__device__ __forceinline__ float wave_max(float v) {
#pragma unroll
    for (int o = 1; o < 64; o <<= 1) v = fmaxf(v, __shfl_xor(v, o));
    return v;
}
__device__ __forceinline__ unsigned pki8(float a, float b, float c, float d) {
    const int ia = (int)__builtin_rintf(a), ib = (int)__builtin_rintf(b), ic = (int)__builtin_rintf(c), id = (int)__builtin_rintf(d);
    return (unsigned)(ia & 255) | ((unsigned)(ib & 255) << 8) | ((unsigned)(ic & 255) << 16) | ((unsigned)id << 24); }
__device__ __forceinline__ float amax4(float m, const f32x4& v) { return fmaxf(fmaxf(m, fmaxf(fabsf(v[0]), fabsf(v[1]))), fmaxf(fabsf(v[2]), fabsf(v[3]))); }
#define NT_LDU4(p) __builtin_nontemporal_load((const GAS u32x4*)(p))
#define NT_LD4(p) __builtin_nontemporal_load((const GAS f32x4*)(p))
__device__ __forceinline__ unsigned ld_agent(const unsigned* p) { return __hip_atomic_load(p, RLX_AGENT); }
__device__ __forceinline__ float ld_agent_f(const float* p) { return __builtin_bit_cast(float, __hip_atomic_load((const unsigned*)p, RLX_AGENT)); }

namespace g8 {
constexpr int BM = 256, BK = 64, HALF = 128, HTB = HALF * BK * 2, NXCD = 8, WGM = 4;
__host__ __device__ __forceinline__ int lds_byte(int r, int c) { const int st = (r >> 4) * 2 + (c >> 5), rr = r & 15, cc = c & 31, ob = rr * 64 + cc * 2; return st * 1024 + (ob ^ (((ob >> 9) & 1) << 5)); }
__host__ __device__ __forceinline__ void stage_rc(int b, int& R, int& C) { const int st = b / 1024, sb = b % 1024, swz = sb ^ (((sb >> 9) & 1) << 5); R = (st >> 1) * 16 + swz / 64; C = (st & 1) * 32 + (swz % 64) / 2; }

struct Unit { const char* a; const char* b; const int* rows; int nkt; int pm, pn, x0, x1; int half; };

__device__ __forceinline__ bool tile_order(int nM, int nN, int G, int c, int i, int& pm, int& pn) {
    const int nwg = nM * nN; const long L = (long)i * G + c; if (L >= nwg) return false;
    int wgid = (int)L; { const int q = nwg / NXCD, r = nwg % NXCD, xcd = wgid % NXCD, off = wgid / NXCD; wgid = (xcd < r ? xcd * (q + 1) : r * (q + 1) + (xcd - r) * q) + off; }
    const int nig = WGM * nN, gid = wgid / nig, fm = gid * WGM, gsz = (nM - fm) < WGM ? (nM - fm) : WGM;
    pm = fm + ((wgid % nig) % gsz); pn = (wgid % nig) / gsz; return true;
}

template <class Epi, class Sched, bool GATHER, bool FP8 = false, bool I8 = false, bool HALFU = false>
__device__ __forceinline__ void gemm_phase(LAS unsigned char* lds, const int lda, const int ldb, const Sched& S, const Epi& E) {
    const int tid = threadIdx.x, wid = __builtin_amdgcn_readfirstlane(tid >> 6), lane = tid & 63, wr = wid >> 2, wc = wid & 3, fr = lane & 15, fq = lane >> 4;
    int Rr[2], Cc[2];
#pragma unroll
    for (int i = 0; i < 2; ++i) stage_rc(tid * 16 + i * 8192, Rr[i], Cc[i]);
    unsigned voffB[2], voffA[2];
#pragma unroll
    for (int i = 0; i < 2; ++i) { voffB[i] = (unsigned)(Rr[i] * ldb + Cc[i]) * 2u; voffA[i] = (unsigned)(Rr[i] * lda + Cc[i]) * 2u; }
    const size_t kstep = (size_t)(BK * 2);
    const size_t hstepA = (size_t)HALF * lda * 2, hstepB = (size_t)HALF * ldb * 2;
    const unsigned ldsw = (unsigned)wid * 1024u;
    const int aoff = lds_byte(wr * 64 + fr, fq * 8), boff = lds_byte(wc * 32 + fr, fq * 8);
    const int aoff8 = lds_byte(wr * 64 + fr, 16 * (fq & 1)) + (fq >> 1) * 1024, boff8 = lds_byte(wc * 32 + fr, 16 * (fq & 1)) + (fq >> 1) * 1024;
#define G8_SA(b, h) (((b) * 2 + (h)) * HTB)
#define G8_SB(b, h) ((4 + (b) * 2 + (h)) * HTB)
#define G8_STAGE(bufoff, gbase, voff) do { _Pragma("unroll") for (int _i = 0; _i < 2; ++_i) \
        __builtin_amdgcn_global_load_lds((const unsigned*)((const char*)(gbase) + (voff)[_i]), (LAS unsigned*)(lds + (bufoff) + ldsw + _i * 8192), 16, 0, 0); } while (0)
#define G8_STAGE_A(bufoff, gbase, h, va) do { if (GATHER) { G8_STAGE(bufoff, gbase, (va)[h]); } else { G8_STAGE(bufoff, (gbase) + (h) * hstepA, voffA); } } while (0)
#define G8_STAGE_B(bufoff, gbase, h) G8_STAGE(bufoff, (gbase) + (h) * hstepB, voffB)
#define G8_LD8(p) (*(const LAS i32x8*)(p))
#define G8_LDA(dst, b, h) do { _Pragma("unroll") for (int m = 0; m < 4; ++m) { if (FP8) dst##8[m] = G8_LD8(lds + G8_SA(b, h) + aoff8 + m * 2048); else { _Pragma("unroll") for (int k = 0; k < 2; ++k) dst[m][k] = *(const LAS bf16x8*)(lds + G8_SA(b, h) + aoff + m * 2048 + k * 1024); } } } while (0)
#define G8_LDB(dst, b, h) do { _Pragma("unroll") for (int n = 0; n < 2; ++n) { if (FP8) dst##8[n] = G8_LD8(lds + G8_SB(b, h) + boff8 + n * 2048); else { _Pragma("unroll") for (int k = 0; k < 2; ++k) dst[n][k] = *(const LAS bf16x8*)(lds + G8_SB(b, h) + boff + n * 2048 + k * 1024); } } } while (0)
#define G8_CAT(x0, x1) __builtin_shufflevector(__builtin_bit_cast(i32x4, x0), __builtin_bit_cast(i32x4, x1), 0, 1, 2, 3, 4, 5, 6, 7)
#define G8_MMA(ai, bj, At, Bt) do { __builtin_amdgcn_s_setprio(1); _Pragma("unroll") for (int m = 0; m < 4; ++m) _Pragma("unroll") for (int n = 0; n < 2; ++n) { \
        if (FP8) asm volatile("v_mfma_scale_f32_16x16x128_f8f6f4 %0, %1, %2, %0, %3, %3 op_sel_hi:[0,0,0]" : "+v"(acc[ai][bj][m][n]) : "v"(Bt##8[n]), "v"(At##8[m]), "v"(one8));     \
        else if (I8) { _Pragma("unroll") for (int k = 0; k < 2; ++k) acc[ai][bj][m][n] = __builtin_bit_cast(f32x4, __builtin_amdgcn_mfma_i32_16x16x64_i8(__builtin_bit_cast(i32x4, Bt[n][k]), __builtin_bit_cast(i32x4, At[m][k]), __builtin_bit_cast(i32x4, acc[ai][bj][m][n]), 0, 0, 0)); }     \
        else { _Pragma("unroll") for (int k = 0; k < 2; ++k) acc[ai][bj][m][n] = __builtin_amdgcn_mfma_f32_16x16x32_bf16(Bt[n][k], At[m][k], acc[ai][bj][m][n], 0, 0, 0); } } \
        __builtin_amdgcn_s_setprio(0); } while (0)
#define G8_WAIT_V(n) asm volatile("s_waitcnt vmcnt(" #n ")" ::: "memory")
#define G8_WAIT_L(n) asm volatile("s_waitcnt lgkmcnt(" #n ")" ::: "memory")
#define G8_BAR __builtin_amdgcn_s_barrier()
#define G8_SCHED __builtin_amdgcn_sched_barrier(0)
#define G8_AOFF(dst, u) do { int _t = tid; asm volatile("" : "+v"(_t)); _Pragma("unroll") for (int _i = 0; _i < 2; ++_i) { int _R, _C; stage_rc(_t * 16 + _i * 8192, _R, _C); \
        _Pragma("unroll") for (int _h = 0; _h < 2; ++_h) { const int _r = (int)ld_agent((const unsigned*)((u).rows + _h * HALF + _R)); dst[_h][_i] = (unsigned)(_r * lda + _C) * 2u; } } } while (0)
    Unit cur, nxt; int ui = 0; cur.half = 0; nxt.half = 0;
    if (!S.next(0, cur)) return;
    unsigned cva[2][2], nva[2][2];
    if (GATHER) { G8_AOFF(cva, cur); }
    f32x4 acc[2][2][4][2];
#pragma unroll
    for (int a = 0; a < 2; ++a)
#pragma unroll
        for (int b = 0; b < 2; ++b)
#pragma unroll
            for (int m = 0; m < 4; ++m)
#pragma unroll
                for (int n = 0; n < 2; ++n) acc[a][b][m][n] = (f32x4){0.f, 0.f, 0.f, 0.f};
    bf16x8 At[4][2], B0[2][2], B1[2][2]; i32x8 At8[4], B08[2], B18[2]; const int one8 = 0x7f7f7f7f;
    const char* cA = cur.a; const char* cB = cur.b;
    G8_STAGE_B(G8_SB(0, 0), cB, 0); G8_STAGE_B(G8_SB(0, 1), cB, 1); G8_STAGE_A(G8_SA(0, 0), cA, 0, cva); G8_STAGE_A(G8_SA(0, 1), cA, 1, cva);
    if (wr == 1) G8_BAR;
    G8_WAIT_V(2); G8_BAR;
    G8_STAGE_B(G8_SB(1, 0), cB + kstep, 0); G8_STAGE_A(G8_SA(1, 0), cA + kstep, 0, cva); G8_STAGE_B(G8_SB(1, 1), cB + kstep, 1);
    G8_WAIT_V(6); G8_BAR;
    for (;;) {
        const bool has_next = S.next(ui + 1, nxt);
        const char* nA = has_next ? nxt.a : cA; const char* nB = has_next ? nxt.b : cB;
        if (GATHER) { if (has_next) { G8_AOFF(nva, nxt); } else {
#pragma unroll
            for (int h = 0; h < 2; ++h) { nva[h][0] = cva[h][0]; nva[h][1] = cva[h][1]; } } }
        const int nt = cur.nkt; const bool hf = HALFU && (cur.half != 0);
        for (int t = 0; t < nt; t += 2) {
            const bool last = (t == nt - 2);
            const char* a1 = cA + (size_t)(t + 1) * kstep;
            const char* a2 = last ? nA : cA + (size_t)(t + 2) * kstep; const char* b2 = last ? nB : cB + (size_t)(t + 2) * kstep;
            const char* a3 = a2 + kstep; const char* b3 = b2 + kstep;
            unsigned va2[2][2];
#pragma unroll
            for (int h = 0; h < 2; ++h)
#pragma unroll
                for (int i = 0; i < 2; ++i) va2[h][i] = (GATHER && last) ? nva[h][i] : cva[h][i];
            G8_LDB(B0, 0, 0); G8_LDB(B1, 0, 1); G8_SCHED; G8_LDA(At, 0, 0); G8_STAGE_A(G8_SA(1, 1), a1, 1, cva);
            G8_WAIT_V(8); G8_WAIT_L(0); G8_BAR; G8_MMA(0, 0, At, B0); G8_MMA(0, 1, At, B1); G8_BAR; G8_SCHED;
            if (!hf) G8_LDA(At, 0, 1); G8_STAGE_B(G8_SB(0, 0), b2, 0); G8_STAGE_B(G8_SB(0, 1), b2, 1); G8_STAGE_A(G8_SA(0, 0), a2, 0, va2);
            G8_WAIT_V(8); G8_WAIT_L(0); G8_BAR; if (!hf) { G8_MMA(1, 0, At, B0); G8_MMA(1, 1, At, B1); } G8_BAR; G8_SCHED;
            G8_LDB(B0, 1, 0); G8_LDB(B1, 1, 1); G8_SCHED; G8_LDA(At, 1, 0); G8_STAGE_A(G8_SA(0, 1), a2, 1, va2);
            G8_WAIT_V(8); G8_WAIT_L(0); G8_BAR; G8_MMA(0, 0, At, B0); G8_MMA(0, 1, At, B1); G8_BAR; G8_SCHED;
            if (!hf) G8_LDA(At, 1, 1); G8_STAGE_B(G8_SB(1, 0), b3, 0); G8_STAGE_B(G8_SB(1, 1), b3, 1); G8_STAGE_A(G8_SA(1, 0), a3, 0, va2);
            G8_WAIT_V(8); G8_WAIT_L(0); G8_BAR; if (!hf) { G8_MMA(1, 0, At, B0); G8_MMA(1, 1, At, B1); } G8_BAR; G8_SCHED;
        }
        if (FP8) asm volatile("s_nop 15\n\ts_nop 15" ::: "memory");
        if (wr == 0) G8_BAR;
        const bool keep = E(acc, cur, wr, wc, fr, fq);
        if (!has_next) break;
        if (!keep) {
#pragma unroll
            for (int a = 0; a < 2; ++a)
#pragma unroll
                for (int b = 0; b < 2; ++b)
#pragma unroll
                    for (int m = 0; m < 4; ++m)
#pragma unroll
                        for (int n = 0; n < 2; ++n) acc[a][b][m][n] = (f32x4){0.f, 0.f, 0.f, 0.f};
        }
        cur = nxt; cA = nA; cB = nB; ++ui;
        if (GATHER) {
#pragma unroll
            for (int h = 0; h < 2; ++h) { cva[h][0] = nva[h][0]; cva[h][1] = nva[h][1]; } }
        if (wr == 1) G8_BAR;
    }
    G8_WAIT_V(0);
    G8_BAR;
#undef G8_SA
#undef G8_SB
#undef G8_STAGE
#undef G8_STAGE_A
#undef G8_STAGE_B
#undef G8_LDA
#undef G8_LD8
#undef G8_LDB
#undef G8_MMA
#undef G8_CAT
#undef G8_WAIT_V
#undef G8_WAIT_L
#undef G8_BAR
#undef G8_SCHED
#undef G8_AOFF
}
}

#define XB_TMO      128
#define XB_XCNT(j)  (256  + 64 * (j))
#define XB_XSUB(j)  (1280 + 64 * (j))
#define XB_XGEN(j)  (2304 + 64 * (j))
#define XB_TOP      3328
#define XB_TOPGEN   3392
#define XCD_BAR_WORDS 3456
#define XB_SPIN_CAP (1u << 18)
__device__ __forceinline__ unsigned xb_ld(unsigned* p)              { return __hip_atomic_load(p, __ATOMIC_RELAXED, __HIP_MEMORY_SCOPE_AGENT); }
__device__ __forceinline__ unsigned xb_add(unsigned* p, unsigned v) { return __hip_atomic_fetch_add(p, v, __ATOMIC_RELAXED, __HIP_MEMORY_SCOPE_AGENT); }
__device__ __forceinline__ unsigned xb_xcc_id() { return (unsigned)__builtin_amdgcn_s_getreg((3 << 11) | 20) & 0xFu; }
#define XB_SPIN(cond, bar) do { unsigned _sp = 0; while (cond) { __builtin_amdgcn_s_sleep(1); \
    if ((++_sp & 255u) == 0u) { if (xb_ld(&(bar)[XB_TMO])) break; if (_sp > XB_SPIN_CAP) { atomicAdd(&(bar)[XB_TMO], 1u); break; } } } } while (0)
struct XcdBarrier { unsigned* bar; unsigned x; volatile LAS unsigned* st; };
__device__ __forceinline__ XcdBarrier xcd_barrier_post(unsigned* bar, volatile LAS unsigned* st) {
    XcdBarrier b; b.bar = bar; b.x = xb_xcc_id(); b.st = st;
    if (threadIdx.x == 0) (void)xb_add(&bar[XB_XCNT(b.x)], 1u);
    return b;
}
__device__ __forceinline__ void xcd_barrier_complete(unsigned* bar, unsigned x, unsigned& nloc, unsigned& nx) {
    const unsigned G = gridDim.x * gridDim.y * gridDim.z;
    unsigned sum, cnt, mine, sp = 0u;
    for (;;) {
        sum = 0u; cnt = 0u; mine = 0u;
#pragma unroll
        for (unsigned j = 0; j < 16; ++j) { const unsigned c = xb_ld(&bar[XB_XCNT(j)]); sum += c; cnt += (c > 0u) ? 1u : 0u; mine = (j == x) ? c : mine; }
        if (sum == G) break;
        __builtin_amdgcn_s_sleep(1);
        if ((++sp & 255u) == 0u) { if (xb_ld(&bar[XB_TMO])) break; if (sp > XB_SPIN_CAP) { atomicAdd(&bar[XB_TMO], 1u); break; } }
    }
    nloc = mine > 0u ? mine : 1u; nx = cnt > 0u ? cnt : 1u;
}
__device__ __forceinline__ void xcd_barrier(const XcdBarrier& b) {
    asm volatile("s_waitcnt vmcnt(0)" ::: "memory");
    __syncthreads();
    if (threadIdx.x == 0) {
        unsigned* bar = b.bar;
        __builtin_amdgcn_s_waitcnt(0);
        unsigned nloc = b.st[0], nx = b.st[1];
        if (nloc == 0u) { xcd_barrier_complete(bar, b.x, nloc, nx); b.st[0] = nloc; b.st[1] = nx; }
        const unsigned old = xb_add(&bar[XB_XSUB(b.x)], 1u);
        const unsigned gen = old / nloc;
        if (old + 1u == (gen + 1u) * nloc) {
            __builtin_amdgcn_fence(__ATOMIC_RELEASE, "agent");
            asm volatile("s_waitcnt vmcnt(0)" ::: "memory");
            const unsigned og = xb_add(&bar[XB_TOP], 1u);
            const unsigned tg = og / nx;
            if (og + 1u == (tg + 1u) * nx) xb_add(&bar[XB_TOPGEN], 1u);
            else XB_SPIN(xb_ld(&bar[XB_TOPGEN]) == tg, bar);
            __builtin_amdgcn_fence(__ATOMIC_ACQUIRE, "agent");
            xb_add(&bar[XB_XGEN(b.x)], 1u);
            asm volatile("s_waitcnt vmcnt(0)" ::: "memory");
        } else {
            XB_SPIN(xb_ld(&bar[XB_XGEN(b.x)]) == gen, bar);
            __builtin_amdgcn_fence(__ATOMIC_ACQUIRE, "agent");
            asm volatile("s_waitcnt vmcnt(0)" ::: "memory");
        }
    }
    __syncthreads();
}

struct Args { const float* in[17]; float* out; unsigned char* ws; int ph_lo, ph_hi; };

struct Frame {
    LAS unsigned char* lds;
    int tid, lane, wave, vcu, G;
    const float *x, *g_mix, *w_in, *qn_a, *kn_a, *sinks, *qn_b, *kn_b, *w_upa, *w_upb, *w_out, *g_ffn, *w_rg, *w_re, *w_ge, *w_ue, *w_de;
    float* out; unsigned char* ws;
};

__device__ __forceinline__ int perm_in(int j) { return 16 * ((j >> 2) & 1) + 4 * (j >> 3) + (j & 3); }

struct CvItem { const float* src; bf16_t* dst; int ldw, ldt; const float* gk; float sc8; };
__device__ __forceinline__ void cv_load(f32x4 (&v)[8], const CvItem& it, int lane) {
#pragma unroll
    for (int j = 0; j < 8; ++j) v[j] = NT_LD4(it.src + (size_t)((lane >> 3) + 8 * j) * it.ldw + 4 * (lane & 7));
    if (it.gk) {
#pragma unroll
        for (int j = 0; j < 8; ++j) v[j] = v[j] * it.gk[(lane >> 3) + 8 * j]; }
    if (it.sc8 != 0.f) {
#pragma unroll
        for (int j = 0; j < 8; ++j) v[j] = v[j] * it.sc8; }
}
__device__ __forceinline__ void cv_to_lds(const f32x4 (&v)[8], LAS float* scr, int lane) {
#pragma unroll
    for (int j = 0; j < 8; ++j) { LAS float* d = scr + ((lane >> 3) + 8 * j) * 33 + 4 * (lane & 7); d[0] = v[j][0]; d[1] = v[j][1]; d[2] = v[j][2]; d[3] = v[j][3]; }
}
__device__ __forceinline__ void cv_store(const CvItem& it, const LAS float* scr, int lane) {
    const int c = lane & 7;
    if (it.sc8 != 0.f) {
#pragma unroll
        for (int j = 0; j < 4; ++j) { const int n = (lane >> 3) + 8 * j; const LAS float* s = scr + (8 * c) * 33 + n;
            u32x2 o; o.x = pk8(s[0 * 33], s[1 * 33], s[2 * 33], s[3 * 33]); o.y = pk8(s[4 * 33], s[5 * 33], s[6 * 33], s[7 * 33]);
            *(GAS u32x2*)((unsigned char*)it.dst + (size_t)perm_in(n) * it.ldt + 8 * c) = o; }
        return; }
#pragma unroll
    for (int j = 0; j < 4; ++j) { const int n = (lane >> 3) + 8 * j; const LAS float* s = scr + (8 * c) * 33 + n;
        u32x4 o; o.x = pk2(s[0 * 33], s[1 * 33]); o.y = pk2(s[2 * 33], s[3 * 33]); o.z = pk2(s[4 * 33], s[5 * 33]); o.w = pk2(s[6 * 33], s[7 * 33]);
        *(GAS u32x4*)(it.dst + (size_t)perm_in(n) * it.ldt + 8 * c) = o; }
}
template <class Dec> __device__ __forceinline__ void convert_list(const Dec& dec, int gw, int NGW, int N, LAS float* scr, int lane) {
    if (gw >= N) return;
    f32x4 v[8]; CvItem cur = dec(gw); cv_load(v, cur, lane);
    for (int it = gw; it < N; it += NGW) {
        cv_to_lds(v, scr, lane);
        const int nx = it + NGW; CvItem nxt = cur; if (nx < N) { nxt = dec(nx); cv_load(v, nxt, lane); }
        LDS_WAIT(); asm volatile("" ::: "memory");
        cv_store(cur, scr, lane);
        LDS_WAIT(); asm volatile("" ::: "memory");
        cur = nxt;
    }
}
__device__ __forceinline__ int std_row0(int n0) { return (n0 & ~255) + 128 * ((n0 >> 5) & 1) + 32 * ((n0 >> 6) & 3); }

__device__ __forceinline__ int w_in_row0(int nb) {
    if (32 * nb >= GA0) { const int n1 = 32 * nb - GA0, isb = n1 >> 11, mc0 = n1 & (DM - 1); return GA0 + (mc0 >> 7) * 256 + 128 * isb + 32 * ((mc0 >> 5) & 3); }
    return std_row0(32 * nb);
}
__device__ __forceinline__ void convert_cols_i8(const Frame& F, const float* W, int ldw, unsigned char* dstbase, float* scales, int nb, int row0) {
    LAS float* scr = (LAS float*)(F.lds + F.wave * 16384);
    volatile LAS float* red = (volatile LAS float*)(F.lds + 12288);
    const int lane = F.lane, w = F.wave;
    const float* src = W + (size_t)(256 * w + (lane >> 3)) * ldw + 32 * nb + 4 * (lane & 7);
    f32x4 v[4][8];
#pragma unroll
    for (int it = 0; it < 4; ++it)
#pragma unroll
        for (int j = 0; j < 8; ++j) v[it][j] = NT_LD4(src + (size_t)(64 * it + 8 * j) * ldw);
    float am = 0.f;
#pragma unroll
    for (int it = 0; it < 4; ++it)
#pragma unroll
        for (int j = 0; j < 8; ++j) am = amax4(am, v[it][j]);
    am = wave_max(am);
    __syncthreads();
    if (lane == 0) red[w] = am;
    __syncthreads();
    float gmx = red[0];
#pragma unroll
    for (int i = 1; i < NWAVES; ++i) gmx = fmaxf(gmx, red[i]);
    const float sc = gmx > 0.f ? 127.f / gmx : 0.f;
    if (F.tid == 0) scales[nb] = gmx * (1.f / 127.f);
    unsigned char* dst = dstbase + (size_t)row0 * DM + 256 * w;
    const int c = lane & 7;
#pragma unroll
    for (int it = 0; it < 4; ++it) {
#pragma unroll
        for (int j = 0; j < 8; ++j) { LAS float* d = scr + ((lane >> 3) + 8 * j) * 33 + 4 * c; const f32x4 q = v[it][j] * sc; d[0] = q[0]; d[1] = q[1]; d[2] = q[2]; d[3] = q[3]; }
        LDS_WAIT(); asm volatile("" ::: "memory");
#pragma unroll
        for (int j = 0; j < 4; ++j) { const int n = (lane >> 3) + 8 * j; const LAS float* sp = scr + (8 * c) * 33 + n;
            u32x2 o; o.x = pki8(sp[0 * 33], sp[1 * 33], sp[2 * 33], sp[3 * 33]); o.y = pki8(sp[4 * 33], sp[5 * 33], sp[6 * 33], sp[7 * 33]);
            *(GAS u32x2*)(dst + 64 * it + (size_t)perm_in(n) * DM + 8 * c) = o; }
        LDS_WAIT(); asm volatile("" ::: "memory");
    }
}

__device__ __forceinline__ void p0_prologue(const Frame& F) {
    LAS float* scr = (LAS float*)(F.lds + F.wave * 16384);
    bf16_t* Wup_t = (bf16_t*)(F.ws + WS_WUP); bf16_t* Wout_t = (bf16_t*)(F.ws + WS_WOUT);
    constexpr int NGRP = INC / 32;
    for (int nb = F.vcu; nb < NGRP; nb += F.G) convert_cols_i8(F, F.w_in, INC, F.ws + WS_WIN8, (float*)(F.ws + WS_WSC), nb, w_in_row0(nb));
    const int nheavy = (F.G < NGRP && 2 * (NGRP % F.G) <= F.G) ? NGRP % F.G : 0;
    if (F.vcu >= nheavy) {
    const int gw = (F.vcu - nheavy) * NWAVES + F.wave, NGW = (F.G - nheavy) * NWAVES;
    f32x4 gm[8];
#pragma unroll
    for (int j = 0; j < 8; ++j) gm[j] = ((const GAS f32x4*)F.g_mix)[F.lane + 64 * j];
    f32x4 nv[8];
    if (gw < NTOK) { const GAS f32x4* xr = (const GAS f32x4*)(F.x + (size_t)gw * DM) + F.lane;
#pragma unroll
        for (int j = 0; j < 8; ++j) nv[j] = NT_LD4(xr + 64 * j); }
    for (int m = gw; m < NTOK; m += NGW) {
        f32x4 v[8]; float s = 0.f;
#pragma unroll
        for (int j = 0; j < 8; ++j) { v[j] = nv[j]; s += (v[j].x * v[j].x + v[j].y * v[j].y) + (v[j].z * v[j].z + v[j].w * v[j].w); }
        if (m + NGW < NTOK) { const GAS f32x4* xr = (const GAS f32x4*)(F.x + (size_t)(m + NGW) * DM) + F.lane;
#pragma unroll
            for (int j = 0; j < 8; ++j) nv[j] = NT_LD4(xr + 64 * j); }
        const float rstd = 1.0f / sqrtf(wave_sum(s) * (1.f / DM) + EPS);
        float am = 0.f;
#pragma unroll
        for (int j = 0; j < 8; ++j) { v[j] = v[j] * rstd * gm[j]; am = amax4(am, v[j]); }
        am = wave_max(am);
        const float sc = am > 0.f ? 127.f / am : 0.f;
        if (F.lane == 0) ((float*)(F.ws + WS_XS))[m] = am * (1.f / 127.f);
#pragma unroll
        for (int j = 0; j < 8; ++j) { const f32x4 y = v[j] * sc; ((GAS unsigned*)(F.ws + WS_X8 + (size_t)m * DM))[F.lane + 64 * j] = pki8(y.x, y.y, y.z, y.w); }
    }
    }
    { bf16_t* GWT = (bf16_t*)(F.ws + WS_GWT);
      for (int idx = F.vcu * 512 + F.tid; idx < 32 * DM; idx += F.G * 512) { const int j = idx >> 11, d = idx & (DM - 1); float v = 0.f;
          if (j < 4) v = F.w_rg[d * 4 + j]; else if (j < 20) v = F.w_re[((size_t)((j - 4) >> 2) * DM + d) * 4 + ((j - 4) & 3)];
          GWT[idx] = (bf16_t)f2bf(v * F.g_ffn[d]); } }
    { GAS u32x4* z = (GAS u32x4*)(F.ws + WS_SL); for (int i = F.vcu * 512 + F.tid; i < (int)(2 * MiB / 16); i += F.G * 512) z[i] = (u32x4){0u, 0u, 0u, 0u}; }
    { GAS u32x4* z = (GAS u32x4*)(F.ws + WS_BK); for (int i = F.vcu * 512 + F.tid; i < (int)((BK_BYTES + 4096) / 16); i += F.G * 512) z[i] = (u32x4){0u, 0u, 0u, 0u}; }
    float* KS = (float*)(F.ws + WS_KSUM);
    for (int i = F.vcu * 512 + F.tid; i < NB * 16 * 8 * 64; i += F.G * 512) KS[i] = 0.f;
}

struct CvBlock { const float* src; unsigned char* dst; const float* gk; int kind, e, isup, nblk, ldt; };
template <bool BF16, class Dec> __device__ __forceinline__ void convert_blocks(const Frame& F, const Dec& dec, int wg, int nwg, int nblocks, int ldw, float sc) {
    constexpr int NR = BF16 ? 16 : 32;
    if (wg >= nblocks) return;
    __syncthreads();
    LAS unsigned char* T = F.lds;
    const int lane = F.lane, w = F.wave;
    f32x4 v[32]; float gl;
    CvBlock cur = dec(wg);
#define CVB_LOAD(blk) do { const float* _s = (blk).src + (size_t)(NR * w) * ldw + 4 * lane; _Pragma("unroll") for (int j = 0; j < NR; ++j) v[j] = NT_LD4(_s + (size_t)j * ldw); \
        gl = (!BF16 && (blk).gk) ? (blk).gk[32 * w + (lane & 31)] * sc : sc; } while (0)
    CVB_LOAD(cur);
    for (int it = wg; it < nblocks; it += nwg) {
        const int sw = 16 * (lane & 15);
        if (BF16) {
#pragma unroll
            for (int p = 0; p < 8; ++p)
#pragma unroll
                for (int i = 0; i < 4; ++i) *(LAS unsigned*)(T + (4 * lane + i) * 256 + ((32 * w + 4 * p) ^ sw)) = pk2(v[2 * p][i], v[2 * p + 1][i]);
        } else {
#pragma unroll
        for (int q = 0; q < 8; ++q) {
            const float g0 = __builtin_bit_cast(float, __builtin_amdgcn_readlane(__builtin_bit_cast(int, gl), 4 * q)), g1 = __builtin_bit_cast(float, __builtin_amdgcn_readlane(__builtin_bit_cast(int, gl), 4 * q + 1)),
                        g2 = __builtin_bit_cast(float, __builtin_amdgcn_readlane(__builtin_bit_cast(int, gl), 4 * q + 2)), g3 = __builtin_bit_cast(float, __builtin_amdgcn_readlane(__builtin_bit_cast(int, gl), 4 * q + 3));
#pragma unroll
            for (int i = 0; i < 4; ++i) *(LAS unsigned*)(T + (4 * lane + i) * 256 + ((32 * w + 4 * q) ^ sw)) = pk8(v[4 * q][i] * g0, v[4 * q + 1][i] * g1, v[4 * q + 2][i] * g2, v[4 * q + 3][i] * g3);
        } }
        const int nx = it + nwg; CvBlock nxt = cur; if (nx < nblocks) { nxt = dec(nx); CVB_LOAD(nxt); }
        LDS_WAIT(); asm volatile("" ::: "memory"); __builtin_amdgcn_s_barrier(); asm volatile("" ::: "memory");
#pragma unroll
        for (int r = 0; r < 8; ++r) { const int n = 32 * w + 4 * r + (lane >> 4), c = lane & 15;
            const u32x4 d = *(const LAS u32x4*)(T + n * 256 + ((16 * c) ^ (16 * ((n >> 2) & 15))));
            int row; if (cur.kind == 0) { const int hc = 256 * cur.nblk + n; row = (hc >> 7) * 256 + 128 * cur.isup + 32 * ((hc >> 5) & 3) + perm_in(hc & 31); } else { const int col = 256 * cur.nblk + n; row = std_row0(col & ~31) + perm_in(col & 31); }
            *(GAS u32x4*)(cur.dst + (size_t)row * cur.ldt + 16 * c) = d; }
        LDS_WAIT(); asm volatile("" ::: "memory"); __builtin_amdgcn_s_barrier(); asm volatile("" ::: "memory");
        cur = nxt;
    }
#undef CVB_LOAD
}
__device__ __forceinline__ void convert_moe_gate_up(const Frame& F, int wg, int nwg, int nblk_end = 2 * NEXP * 8 * 2) {
    struct Dec { const float *w_ge, *w_ue, *g_ffn; unsigned char* Wgu;
        __device__ __forceinline__ CvBlock operator()(int r) const { const int nblk = r & 1, kb = (r >> 1) & 7, e = (r >> 4) & 15, isup = r >> 8;
            return CvBlock{(isup ? w_ue : w_ge) + (size_t)e * DM * DEXP + (size_t)(256 * kb) * DEXP + 256 * nblk, Wgu + (size_t)e * 1024 * DM + 256 * kb, g_ffn + 256 * kb, 0, e, isup, nblk, DM}; } };
    convert_blocks<false>(F, Dec{F.w_ge, F.w_ue, F.g_ffn, F.ws + WS_WGU}, wg, nwg, nblk_end, DEXP, SW8);
}
__device__ __forceinline__ void convert_moe_down(const Frame& F, int wg, int nwg) {
    struct Dec { const float* w_de; unsigned char* Wd;
        __device__ __forceinline__ CvBlock operator()(int r) const { const int nblk = r & 7, kb = (r >> 3) & 1, e = r >> 4;
            return CvBlock{w_de + (size_t)e * DEXP * DM + (size_t)(256 * kb) * DM + 256 * nblk, Wd + (size_t)e * DM * DEXP + 256 * kb, nullptr, 1, e, 0, nblk, DEXP}; } };
    convert_blocks<false>(F, Dec{F.w_de, F.ws + WS_WD}, wg, nwg, NEXP * 2 * 8, DM, SD8);
}
__device__ __forceinline__ void convert_up_out_blocks(const Frame& F, int wg, int nwg) {
    struct DecU { const float *w_upa, *w_upb; unsigned char* Wup;
        __device__ __forceinline__ CvBlock operator()(int r) const { const int nblk = r & 7, kb = (r >> 3) & 3, half = r >> 5;
            return CvBlock{(half ? w_upb : w_upa) + (size_t)(256 * kb) * DM + 256 * nblk, Wup + (size_t)half * DM * 1024 + 256 * kb, nullptr, 1, 0, 0, nblk, 1024}; } };
    convert_blocks<false>(F, DecU{F.w_upa, F.w_upb, F.ws + WS_WUP}, wg, nwg, 64, DM, SWU8);
    for (int nb = wg; nb < DM / 32; nb += nwg) convert_cols_i8(F, F.w_out, DM, F.ws + WS_WOUT, (float*)(F.ws + WS_WOSC), nb, std_row0(32 * nb));
    __syncthreads();
}

struct SchedTiles {
    const char* A; const char* Bt; int nM, nN, K, G, c;
    __device__ __forceinline__ bool next(int i, g8::Unit& u) const {
        int pm, pn; if (!g8::tile_order(nM, nN, G, c, i, pm, pn)) return false;
        u.a = A + (size_t)pm * 256 * K * 2; u.b = Bt + (size_t)pn * 256 * K * 2; u.rows = nullptr; u.nkt = K / 64; u.pm = pm; u.pn = pn; u.x0 = 0; u.x1 = 0; return true;
    }
};
struct SchedIn8 {
    const char* A; const char* Bt; int G, c;
    __device__ __forceinline__ bool next(int i, g8::Unit& u) const {
        int pm, pn; if (!g8::tile_order(NTOK / 256, INC / 256, G, c, i, pm, pn)) return false;
        u.a = A + (size_t)pm * 256 * DM; u.b = Bt + (size_t)pn * 256 * DM; u.rows = nullptr; u.nkt = DM / 128; u.pm = pm; u.pn = pn; u.x0 = 0; u.x1 = 0; return true;
    }
};
struct EpiGate8 {
    bf16_t* P; const float* XS; const float* WSC;
    __device__ __forceinline__ bool operator()(f32x4 (&acc)[2][2][4][2], const g8::Unit& u, int wr, int wc, int fr, int fq) const {
        const int t = u.pn - NT_QKV, mcol = t * 128 + wc * 32 + 8 * fq;
        const float wa = ld_agent_f(WSC + GA0 / 32 + 4 * t + wc) * -LOG2E, wb = ld_agent_f(WSC + GB0 / 32 + 4 * t + wc) * -LOG2E;
#pragma unroll
        for (int ai = 0; ai < 2; ++ai)
#pragma unroll
            for (int m = 0; m < 4; ++m) { const int row = u.pm * 256 + ai * 128 + wr * 64 + m * 16 + fr;
                const float xr = ld_agent_f(XS + row), sa_ = xr * wa, sb_ = xr * wb;
                float rr[8], sbv[8];
#pragma unroll
                for (int n = 0; n < 2; ++n) { const i32x4 ia = __builtin_bit_cast(i32x4, acc[ai][0][m][n]), ib = __builtin_bit_cast(i32x4, acc[ai][1][m][n]);
#pragma unroll
                    for (int i = 0; i < 4; ++i) { const float ea = 1.0f + __builtin_amdgcn_exp2f((float)ia[i] * sa_), eb = 1.0f + __builtin_amdgcn_exp2f((float)ib[i] * sb_);
                        rr[4 * n + i] = eb * __builtin_amdgcn_rcpf(ea); sbv[4 * n + i] = __builtin_amdgcn_rcpf(eb); } }
                u32x4 wr_, ws_; wr_.x = pk2(rr[0], rr[1]); wr_.y = pk2(rr[2], rr[3]); wr_.z = pk2(rr[4], rr[5]); wr_.w = pk2(rr[6], rr[7]);
                ws_.x = pk2(sbv[0], sbv[1]); ws_.y = pk2(sbv[2], sbv[3]); ws_.z = pk2(sbv[4], sbv[5]); ws_.w = pk2(sbv[6], sbv[7]);
                *(GAS u32x4*)(P + (size_t)row * INC + GA0 + mcol) = wr_; *(GAS u32x4*)(P + (size_t)row * INC + GB0 + mcol) = ws_; }
        return false;
    }
};
struct EpiProj {
    bf16_t* P; float* KS; const float *qn_a, *kn_a, *qn_b, *kn_b; const float* XS; const float* WSC;
    __device__ __forceinline__ bool operator()(f32x4 (&acc)[2][2][4][2], const g8::Unit& u, int wr, int wc, int fr, int fq) const {
        const int pn = u.pn;
        int kind; const float* gain = nullptr;
        if (pn < 4) { kind = 2; gain = qn_a; } else if (pn == 4) { if (wc < 2) { kind = 1; gain = kn_a; } else kind = 0; }
        else if (pn < 9) { kind = 2; gain = qn_b; } else if (pn < 13) { kind = 3; gain = kn_b; } else kind = 0;
        const int colbase = pn * 256 + wc * 64 + 8 * fq;
        { const float w0 = ld_agent_f(WSC + pn * 8 + wc * 2), w1 = ld_agent_f(WSC + pn * 8 + wc * 2 + 1);
#pragma unroll
          for (int ai = 0; ai < 2; ++ai)
#pragma unroll
              for (int m = 0; m < 4; ++m) { const float xr = ld_agent_f(XS + u.pm * 256 + ai * 128 + wr * 64 + m * 16 + fr);
#pragma unroll
                  for (int bj = 0; bj < 2; ++bj) { const float sc = xr * (bj ? w1 : w0);
#pragma unroll
                      for (int n = 0; n < 2; ++n) { const i32x4 iv = __builtin_bit_cast(i32x4, acc[ai][bj][m][n]); acc[ai][bj][m][n] = (f32x4){(float)iv[0] * sc, (float)iv[1] * sc, (float)iv[2] * sc, (float)iv[3] * sc}; } } } }
        f32x4 gv[2][2];
        if (kind != 0) {
#pragma unroll
            for (int bj = 0; bj < 2; ++bj)
#pragma unroll
                for (int n = 0; n < 2; ++n) gv[bj][n] = *(const GAS f32x4*)(gain + 32 * bj + 8 * fq + 4 * n);
            if (kind == 2) {
#pragma unroll
                for (int bj = 0; bj < 2; ++bj)
#pragma unroll
                    for (int n = 0; n < 2; ++n) gv[bj][n] = gv[bj][n] * QSCALE;
            }
        }
        f32x4 ks[2][2];
#pragma unroll
        for (int bj = 0; bj < 2; ++bj)
#pragma unroll
            for (int n = 0; n < 2; ++n) ks[bj][n] = (f32x4){0.f, 0.f, 0.f, 0.f};
#pragma unroll
        for (int ai = 0; ai < 2; ++ai)
#pragma unroll
            for (int m = 0; m < 4; ++m) { const int row = u.pm * 256 + ai * 128 + wr * 64 + m * 16 + fr;
                if (kind != 0) {
                    float s = 0.f;
#pragma unroll
                    for (int bj = 0; bj < 2; ++bj)
#pragma unroll
                        for (int n = 0; n < 2; ++n) { const f32x4 v = acc[ai][bj][m][n]; s += (v[0] * v[0] + v[1] * v[1]) + (v[2] * v[2] + v[3] * v[3]); }
                    s += __shfl_xor(s, 16); s += __shfl_xor(s, 32);
                    const float rstd = 1.0f / sqrtf(s * (1.f / 64.f) + EPS);
#pragma unroll
                    for (int bj = 0; bj < 2; ++bj)
#pragma unroll
                        for (int n = 0; n < 2; ++n) { acc[ai][bj][m][n] = acc[ai][bj][m][n] * rstd * gv[bj][n]; if (kind == 3) ks[bj][n] += acc[ai][bj][m][n]; }
                }
#pragma unroll
                for (int bj = 0; bj < 2; ++bj) { u32x4 w; const f32x4 a = acc[ai][bj][m][0], b = acc[ai][bj][m][1];
                    w.x = pk2(a[0], a[1]); w.y = pk2(a[2], a[3]); w.z = pk2(b[0], b[1]); w.w = pk2(b[2], b[3]);
                    *(GAS u32x4*)(P + (size_t)row * INC + colbase + 32 * bj) = w; } }
        if (kind == 3) {
            const int bb = u.pm >> 3, blk = u.pm & 7, h = (pn - 9) * 4 + wc;
            float* dst = KS + ((size_t)((bb * 16 + h) * 8 + blk)) * 64 + 8 * fq;
#pragma unroll
            for (int bj = 0; bj < 2; ++bj)
#pragma unroll
                for (int n = 0; n < 2; ++n)
#pragma unroll
                    for (int i = 0; i < 4; ++i) { float v = ks[bj][n][i]; v += __shfl_xor(v, 1); v += __shfl_xor(v, 2); v += __shfl_xor(v, 4); v += __shfl_xor(v, 8);
                        if (fr == 0) atomicAdd(dst + 32 * bj + 4 * n + i, v); }
        }
        return false;
    }
};

struct EpiIn8 { EpiProj p; EpiGate8 g;
    __device__ __forceinline__ bool operator()(f32x4 (&acc)[2][2][4][2], const g8::Unit& u, int wr, int wc, int fr, int fq) const { return (u.pn >= NT_QKV) ? g(acc, u, wr, wc, fr, fq) : p(acc, u, wr, wc, fr, fq); }
};

__device__ __forceinline__ void load_q64(float (&q)[64], const bf16_t* p) {
#pragma unroll
    for (int c = 0; c < 8; ++c) { const u32x4 w = *(const GAS u32x4*)(p + 8 * c);
        q[8 * c + 0] = bf_lo(w.x); q[8 * c + 1] = bf_hi(w.x); q[8 * c + 2] = bf_lo(w.y); q[8 * c + 3] = bf_hi(w.y);
        q[8 * c + 4] = bf_lo(w.z); q[8 * c + 5] = bf_hi(w.z); q[8 * c + 6] = bf_lo(w.w); q[8 * c + 7] = bf_hi(w.w); }
}
__device__ __forceinline__ float dot_q64(const float (&q)[64], const bf16_t* p) {
    float s0 = 0.f, s1 = 0.f;
#pragma unroll
    for (int c = 0; c < 8; ++c) { const u32x4 w = *(const GAS u32x4*)(p + 8 * c);
        s0 += q[8 * c + 0] * bf_lo(w.x); s1 += q[8 * c + 1] * bf_hi(w.x); s0 += q[8 * c + 2] * bf_lo(w.y); s1 += q[8 * c + 3] * bf_hi(w.y);
        s0 += q[8 * c + 4] * bf_lo(w.z); s1 += q[8 * c + 5] * bf_hi(w.z); s0 += q[8 * c + 6] * bf_lo(w.w); s1 += q[8 * c + 7] * bf_hi(w.w); }
    return s0 + s1;
}
__device__ __forceinline__ void attn_naive(const Frame& F) {
    const bf16_t* P = (const bf16_t*)(F.ws + WS_PROJ); const float* KS = (const float*)(F.ws + WS_KSUM);
    bf16_t* OA = (bf16_t*)(F.ws + WS_XN); bf16_t* OB = OA + (size_t)NTOK * 1024;
    LAS float* pbuf = (LAS float*)(F.lds + F.wave * 4096);
    const int gw = F.vcu * NWAVES + F.wave, NGW = F.G * NWAVES, lane = F.lane;
    const int NTASK = 2 * NB * 16 * SEQ;
    for (int k = 0; k * NGW < NTASK; ++k) {
        const int base = k * NGW; const int idx = base + ((gw + 37 * k) % NGW);
        if (idx >= NTASK) continue;
        const int which = idx / (NB * 16 * SEQ); const int r = idx % (NB * 16 * SEQ);
        const int b = r / (16 * SEQ), h = (r / SEQ) % 16, s = r % SEQ;
        const size_t row = (size_t)b * SEQ + s;
        const float slope = __builtin_amdgcn_exp2f(-0.5f * (float)(h + 1)) * LOG2E;
        float q[64];
        if (which == 0) {
            const int kv = h >> 3;
            load_q64(q, P + row * INC + QA0 + h * 64);
            float lsum = 0.f;
#pragma unroll
            for (int c = 0; c < 2; ++c) { const int kpos = s - 127 + lane + 64 * c; float p = 0.f;
                if (kpos >= 0) { const float sc = dot_q64(q, P + ((size_t)b * SEQ + kpos) * INC + KA0 + kv * 64) - slope * (float)(s - kpos); p = __builtin_amdgcn_exp2f(sc); }
                pbuf[64 * c + lane] = p; lsum += p; }
            lsum = wave_sum(lsum) + __builtin_amdgcn_exp2f(F.sinks[h] * LOG2E);
            LDS_WAIT(); asm volatile("" ::: "memory");
            float o = 0.f;
            for (int j = 0; j < 128; ++j) { const int kpos = s - 127 + j; if (kpos < 0) continue;
                const float v = bf_lo((unsigned)P[((size_t)b * SEQ + kpos) * INC + VA0 + kv * 64 + lane]); o += pbuf[j] * v; }
            OA[row * 1024 + h * 64 + lane] = (bf16_t)f2bf(o / lsum);
            LDS_WAIT(); asm volatile("" ::: "memory");
        } else {
            const int t = s >> 8;
            load_q64(q, P + row * INC + QB0 + h * 64);
            float g = -INFINITY;
            if (lane < t) { const float* kr = KS + ((size_t)((b * 16 + h) * 8 + lane)) * 64; float a = 0.f;
#pragma unroll
                for (int d = 0; d < 64; ++d) a += q[d] * ld_agent_f(kr + d);
                g = a; }
            unsigned selmask;
            if (t <= 3) selmask = (1u << t) - 1u;
            else { int rank = 0;
#pragma unroll
                for (int i = 0; i < 7; ++i) { const float gi = __shfl(g, i); if (i < t && (gi > g || (gi == g && i < lane))) ++rank; }
                selmask = (unsigned)__ballot(lane < t && rank < 3); }
            float lsum = 0.f; int nslot = 0; int blk_of[4] = {0, 0, 0, 0};
            for (int j = 0; j <= t; ++j) {
                if (j < t && !((selmask >> j) & 1u)) continue;
#pragma unroll
                for (int c = 0; c < 4; ++c) { const int kpos = 256 * j + 64 * c + lane; float p = 0.f;
                    if (kpos <= s) { const float sc = dot_q64(q, P + ((size_t)b * SEQ + kpos) * INC + KB0 + h * 64) - slope * (float)(s - kpos); p = __builtin_amdgcn_exp2f(sc); }
                    pbuf[nslot * 256 + 64 * c + lane] = p; lsum += p; }
                if (nslot == 0) blk_of[0] = j; else if (nslot == 1) blk_of[1] = j; else if (nslot == 2) blk_of[2] = j; else blk_of[3] = j;
                ++nslot;
            }
            lsum = wave_sum(lsum);
            LDS_WAIT(); asm volatile("" ::: "memory");
            float o = 0.f;
            for (int sl = 0; sl < nslot; ++sl) { const int j = sl == 0 ? blk_of[0] : sl == 1 ? blk_of[1] : sl == 2 ? blk_of[2] : blk_of[3];
                for (int kk = 0; kk < 256; ++kk) { const int kpos = 256 * j + kk; if (kpos > s) break;
                    const float v = bf_lo((unsigned)P[((size_t)b * SEQ + kpos) * INC + VB0 + h * 64 + lane]); o += pbuf[sl * 256 + kk] * v; } }
            OB[row * 1024 + h * 64 + lane] = (bf16_t)f2bf(o / lsum);
            LDS_WAIT(); asm volatile("" ::: "memory");
        }
    }
}

namespace att {
typedef float f32x16 __attribute__((ext_vector_type(16)));
typedef short s16x4 __attribute__((ext_vector_type(4)));
typedef __bf16 bf16x2_t __attribute__((ext_vector_type(2)));
__device__ __forceinline__ unsigned cvtpk(float lo, float hi) { f32x2 v = {lo, hi}; bf16x2_t b = __builtin_convertvector(v, bf16x2_t); return __builtin_bit_cast(unsigned, b); }
__device__ __forceinline__ s16x4 vtr(const LAS char* p) { return __builtin_bit_cast(s16x4, __builtin_amdgcn_ds_read_tr16_b64_v4i16((LAS s16x4*)p)); }
__device__ __forceinline__ void tile_map(int wave, int lane, int& key, int& chunk) { chunk = lane & 7; key = 8 * wave + (((lane >> 3) + (lane & 7)) & 7); }
__device__ __forceinline__ int k_off(int key, int chunk) { return chunk * 1024 + key * 16; }
__device__ __forceinline__ int v_off(int key, int chunk) { return ((chunk >> 2) * 4 + (key >> 4)) * 1024 + (key & 15) * 64 + (chunk & 3) * 16; }

__device__ __forceinline__ void tile_qk(f32x16& p0, f32x16& p1, const LAS char* Kt, const bf16x8 (&qr)[4], float base_l, float ch, int lane) {
    const int r32 = lane & 31, hi = lane >> 5;
#pragma unroll
    for (int r = 0; r < 16; ++r) { p0[r] = base_l + ch * (float)((r & 3) + 8 * (r >> 2)); p1[r] = p0[r] + 32.f * ch; }
    const LAS char* kp = Kt + hi * 1024 + r32 * 16;
    bf16x8 kf[8];
#pragma unroll
    for (int d0 = 0; d0 < 4; ++d0) { kf[2 * d0] = *(const LAS bf16x8*)(kp + d0 * 2048); kf[2 * d0 + 1] = *(const LAS bf16x8*)(kp + d0 * 2048 + 512); }
    __builtin_amdgcn_s_setprio(1);
#pragma unroll
    for (int d0 = 0; d0 < 4; ++d0) {
        p0 = __builtin_amdgcn_mfma_f32_32x32x16_bf16(kf[2 * d0], qr[d0], p0, 0, 0, 0);
        p1 = __builtin_amdgcn_mfma_f32_32x32x16_bf16(kf[2 * d0 + 1], qr[d0], p1, 0, 0, 0);
    }
    __builtin_amdgcn_s_setprio(0);
}
template <int MODE>
__device__ __forceinline__ void tile_sm(f32x16& p0, f32x16& p1, u32x4 (&pw)[4], float& lsum, int qrel, int lane) {
    const int hi = lane >> 5;
    if (MODE != 0) {
#pragma unroll
        for (int r = 0; r < 16; ++r) { const int kk = (r & 3) + 8 * (r >> 2) + 4 * hi; const int d0_ = qrel - kk, d1_ = d0_ - 32;
            const bool ok0 = MODE == 1 ? (d0_ >= 0) : (d0_ >= 0 && d0_ < 128), ok1 = MODE == 1 ? (d1_ >= 0) : (d1_ >= 0 && d1_ < 128);
            p0[r] = ok0 ? p0[r] : -INFINITY; p1[r] = ok1 ? p1[r] : -INFINITY; }
    }
    float s = 0.f;
#pragma unroll
    for (int r = 0; r < 16; ++r) { p0[r] = __builtin_amdgcn_exp2f(p0[r]); p1[r] = __builtin_amdgcn_exp2f(p1[r]); s += p0[r] + p1[r]; }
    lsum += s;
#pragma unroll
    for (int i = 0; i < 4; ++i) { pw[0][i] = cvtpk(p0[2 * i], p0[2 * i + 1]); pw[1][i] = cvtpk(p0[8 + 2 * i], p0[8 + 2 * i + 1]); pw[2][i] = cvtpk(p1[2 * i], p1[2 * i + 1]); pw[3][i] = cvtpk(p1[8 + 2 * i], p1[8 + 2 * i + 1]); }
}
__device__ __forceinline__ void tile_pv(f32x16 (&ot)[2], const LAS char* Vt, const u32x4 (&pw)[4], int lane) {
    const int hi = lane >> 5;
    const LAS char* vp = Vt + ((lane >> 4) & 1) * 32 + (lane & 3) * 8 + (4 * hi + ((lane & 15) >> 2)) * 64;
#pragma unroll
    for (int dh = 0; dh < 2; ++dh) {
        bf16x8 vf[4];
#pragma unroll
        for (int ks = 0; ks < 4; ++ks) { const s16x4 lo = vtr(vp + dh * 4096 + ks * 1024), hh = vtr(vp + dh * 4096 + ks * 1024 + 512);
            vf[ks] = (bf16x8){lo[0], lo[1], lo[2], lo[3], hh[0], hh[1], hh[2], hh[3]}; }
        __builtin_amdgcn_s_setprio(1);
#pragma unroll
        for (int ks = 0; ks < 4; ++ks) ot[dh] = __builtin_amdgcn_mfma_f32_32x32x16_bf16(vf[ks], __builtin_bit_cast(bf16x8, pw[ks]), ot[dh], 0, 0, 0);
        __builtin_amdgcn_s_setprio(0);
    }
}
template <int MODE>
__device__ __forceinline__ void tile_step(const LAS char* Kt, const LAS char* Vt, const bf16x8 (&qr)[4], f32x16 (&ot)[2], float& lsum, float base_l, float ch, int qrel, int lane) {
    f32x16 p0, p1; u32x4 pw[4];
    tile_qk(p0, p1, Kt, qr, base_l, ch, lane);
    tile_sm<MODE>(p0, p1, pw, lsum, qrel, lane);
    tile_pv(ot, Vt, pw, lane);
}
__device__ __forceinline__ void store_o(unsigned char* orow, const f32x16 (&ot)[2], float inv, int hi) {
    const float sc = inv * SO8;
#pragma unroll
    for (int dh = 0; dh < 2; ++dh)
#pragma unroll
        for (int g = 0; g < 4; ++g) { float q[4];
#pragma unroll
            for (int e = 0; e < 4; ++e) q[e] = fminf(fmaxf(ot[dh][4 * g + e] * sc, -448.f), 448.f);
            *(GAS unsigned*)(orow + 32 * dh + 8 * g + 4 * hi) = pk8(q[0], q[1], q[2], q[3]); }
}
__device__ __forceinline__ void load_q(bf16x8 (&qr)[4], const bf16_t* qrow, int hi) {
#pragma unroll
    for (int d0 = 0; d0 < 4; ++d0) qr[d0] = *(const GAS bf16x8*)(qrow + 16 * d0 + 8 * hi);
}

__device__ __forceinline__ void swa_unit(const Frame& F, LAS char* L, int b, int n, int kv, int gh) {
    const bf16_t* P = (const bf16_t*)(F.ws + WS_PROJ); unsigned char* OA = F.ws + WS_OCAT;
    const int lane = F.lane, w = F.wave, r32 = lane & 31, hi = lane >> 5;
    int key, chunk; tile_map(w, lane, key, chunk);
    const int wb = 128 * n - 128;
    u32x4 kr[4], vr[4];
#pragma unroll
    for (int i = 0; i < 4; ++i) if (n > 0 || i >= 2) { const bf16_t* src = P + ((size_t)b * SEQ + wb + 64 * i + key) * INC + kv * 64 + chunk * 8;
        kr[i] = *(const GAS u32x4*)(src + KA0); vr[i] = *(const GAS u32x4*)(src + VA0); }
#pragma unroll
    for (int i = 0; i < 4; ++i) if (n > 0 || i >= 2) { *(LAS u32x4*)(L + i * 8192 + k_off(key, chunk)) = kr[i]; *(LAS u32x4*)(L + 32768 + i * 8192 + v_off(key, chunk)) = vr[i]; }
    LDS_WAIT(); __syncthreads();
    const int hq = kv * 8 + gh * 4 + (w >> 1);
    const float ch = __builtin_amdgcn_exp2f(-0.5f * (float)(hq + 1)) * LOG2E;
    const float sink = __builtin_amdgcn_exp2f(F.sinks[hq] * LOG2E);
#pragma unroll 1
    for (int sub = 0; sub < 2; ++sub) {
        const int q0w = 64 * (w & 1) + 32 * sub, qw = 128 + q0w + r32;
        const size_t row = (size_t)b * SEQ + 128 * n + q0w + r32;
        bf16x8 qr[4]; load_q(qr, P + row * INC + QA0 + hq * 64, hi);
        f32x16 ot[2]; float lsum = 0.f;
#pragma unroll
        for (int r = 0; r < 16; ++r) { ot[0][r] = 0.f; ot[1][r] = 0.f; }
        const int i0 = q0w >> 6;
#pragma unroll 1
        for (int i = i0; i < i0 + 3; ++i) { if (n == 0 && i < 2) continue;
            tile_step<2>(L + i * 8192, L + 32768 + i * 8192, qr, ot, lsum, ch * (float)(64 * i - qw + 4 * hi), ch, qw - 64 * i, lane); }
        lsum += __shfl_xor(lsum, 32); lsum += sink;
        store_o(OA + row * 1024 + hq * 64, ot, 1.0f / lsum, hi);
    }
    __syncthreads();
}
__device__ __forceinline__ void moba_unit(const Frame& F, LAS char* L, int b, int h, int t) {
    const bf16_t* P = (const bf16_t*)(F.ws + WS_PROJ); const float* KS = (const float*)(F.ws + WS_KSUM); unsigned char* OB = F.ws + WS_OCAT + (size_t)NTOK * 1024;
    const int lane = F.lane, w = F.wave, r32 = lane & 31, hi = lane >> 5;
    int key, chunk; tile_map(w, lane, key, chunk);
    const int qpos = 256 * t + 32 * w + r32;
    const size_t row = (size_t)b * SEQ + qpos;
    bf16x8 qr[4]; load_q(qr, P + row * INC + QB0 + h * 64, hi);
    const float ch = __builtin_amdgcn_exp2f(-0.5f * (float)(h + 1)) * LOG2E;
    unsigned selmask = (1u << t) - 1u;
    if (t > 3) {
        float g[7];
#pragma unroll
        for (int j = 0; j < 7; ++j) { float a = 0.f;
            if (j < t) { const float* kr = KS + ((size_t)((b * 16 + h) * 8 + j)) * 64 + 8 * hi;
#pragma unroll
                for (int d0 = 0; d0 < 4; ++d0) { const f32x4 k0 = *(const GAS f32x4*)(kr + 16 * d0), k1 = *(const GAS f32x4*)(kr + 16 * d0 + 4); const u32x4 qw = __builtin_bit_cast(u32x4, qr[d0]);
                    a += bf_lo(qw.x) * k0[0] + bf_hi(qw.x) * k0[1] + bf_lo(qw.y) * k0[2] + bf_hi(qw.y) * k0[3] + bf_lo(qw.z) * k1[0] + bf_hi(qw.z) * k1[1] + bf_lo(qw.w) * k1[2] + bf_hi(qw.w) * k1[3]; }
                a += __shfl_xor(a, 32); }
            g[j] = (j < t) ? a : -INFINITY; }
        selmask = 0u;
#pragma unroll
        for (int j = 0; j < 7; ++j) { int rank = 0;
#pragma unroll
            for (int i = 0; i < 7; ++i) if (i != j) rank += (g[i] > g[j] || (g[i] == g[j] && i < j)) ? 1 : 0;
            if (j < t && rank < 3) selmask |= 1u << j; }
    }
    f32x16 ot[2]; float lsum = 0.f;
#pragma unroll
    for (int r = 0; r < 16; ++r) { ot[0][r] = 0.f; ot[1][r] = 0.f; }
    const int NS = 2 * (t + 1);
    const bf16_t* src0 = P + ((size_t)b * SEQ + key) * INC + h * 64 + chunk * 8;
    const int ko = k_off(key, chunk), vo = v_off(key, chunk);
#define MOBA_LOAD(R, step) do { const bf16_t* _s = src0 + (size_t)(128 * (step)) * INC; R[0] = *(const GAS u32x4*)(_s + KB0); R[1] = *(const GAS u32x4*)(_s + (size_t)64 * INC + KB0); \
        R[2] = *(const GAS u32x4*)(_s + VB0); R[3] = *(const GAS u32x4*)(_s + (size_t)64 * INC + VB0); } while (0)
#define MOBA_STEP(R, it) do { LAS char* B0 = L + ((it) & 1) * 32768; \
        *(LAS u32x4*)(B0 + ko) = R[0]; *(LAS u32x4*)(B0 + 8192 + ko) = R[1]; *(LAS u32x4*)(B0 + 16384 + vo) = R[2]; *(LAS u32x4*)(B0 + 24576 + vo) = R[3]; \
        LDS_WAIT(); asm volatile("" ::: "memory"); __builtin_amdgcn_s_barrier(); asm volatile("" ::: "memory");     \
        if ((it) + 2 < NS) MOBA_LOAD(R, (it) + 2); \
        const int j = (it) >> 1, tb = 128 * (it); \
        const bool past = j < t; const bool sel = past ? ((selmask >> j) & 1u) != 0u : true; \
        const int dg = past ? 99 : (w >> 1); \
        _Pragma("unroll 1") for (int c = 0; c < 2; ++c) { \
            const int tc = ((it) & 1) * 2 + c, tbc = tb + 64 * c; \
            const float bl = sel ? ch * (float)(tbc - qpos + 4 * hi) : -1e30f; \
            if (tc < dg) tile_step<0>(B0 + c * 8192, B0 + 16384 + c * 8192, qr, ot, lsum, bl, ch, 0, lane); \
            else if (tc == dg) tile_step<1>(B0 + c * 8192, B0 + 16384 + c * 8192, qr, ot, lsum, bl, ch, qpos - tbc, lane); } } while (0)
    u32x4 Ra[4], Rb[4];
    MOBA_LOAD(Ra, 0); MOBA_LOAD(Rb, 1);
#pragma unroll 1
    for (int it = 0; it < NS; it += 2) { MOBA_STEP(Ra, it); MOBA_STEP(Rb, it + 1); }
#undef MOBA_LOAD
#undef MOBA_STEP
    lsum += __shfl_xor(lsum, 32);
    store_o(OB + row * 1024 + h * 64, ot, 1.0f / lsum, hi);
    __syncthreads();
}
__device__ __forceinline__ void attn_phase(const Frame& F) {
    LAS char* L = (LAS char*)F.lds;
    { const int v = F.vcu; swa_unit(F, L, v >> 6, (v >> 2) & 15, (v >> 1) & 1, v & 1); }
    { const int bh = F.vcu >> 2, pr = F.vcu & 3; moba_unit(F, L, bh >> 4, bh & 15, 7 - pr); moba_unit(F, L, bh >> 4, bh & 15, pr); }
}
}

struct SchedUp {
    const char* A; const char* Bt; int G, c;
    __device__ __forceinline__ bool next(int i, g8::Unit& u) const {
        if (i >= 2) return false; int pm, pn; if (!g8::tile_order(32, 8, G, c, 0, pm, pn)) return false;
        u.a = A + ((size_t)i * NTOK + (size_t)pm * 256) * 1024; u.b = Bt + ((size_t)i * DM + (size_t)pn * 256) * 1024; u.rows = nullptr; u.nkt = 8; u.pm = pm; u.pn = pn; u.x0 = i; u.x1 = 0; return true;
    }
};
struct EpiUp {
    const bf16_t* P; unsigned char* MG8;
    float* PM; float* RS; unsigned* PCNT; LAS float* xl;
    __device__ __forceinline__ bool operator()(f32x4 (&acc)[2][2][4][2], const g8::Unit& u, int wr, int wc, int fr, int fq) const {
        const int col = u.pn * 256 + wc * 64 + 8 * fq; const int gofs = (u.x0 == 0) ? GA0 : GB0;
#pragma unroll
        for (int ai = 0; ai < 2; ++ai) {
            u32x4 gv[4][2];
#pragma unroll
            for (int m = 0; m < 4; ++m)
#pragma unroll
                for (int bj = 0; bj < 2; ++bj) gv[m][bj] = NT_LDU4(P + (size_t)(u.pm * 256 + ai * 128 + wr * 64 + m * 16 + fr) * INC + gofs + col + 32 * bj);
#pragma unroll
            for (int m = 0; m < 4; ++m)
#pragma unroll
                for (int bj = 0; bj < 2; ++bj) { const u32x4 g = gv[m][bj]; f32x4& v0 = acc[ai][bj][m][0]; f32x4& v1 = acc[ai][bj][m][1];
                    v0[0] *= bf_lo(g.x); v0[1] *= bf_hi(g.x); v0[2] *= bf_lo(g.y); v0[3] *= bf_hi(g.y); v1[0] *= bf_lo(g.z); v1[1] *= bf_hi(g.z); v1[2] *= bf_lo(g.w); v1[3] *= bf_hi(g.w); }
        }
        if (u.x0 == 0) return true;
        const int tid = threadIdx.x;
#pragma unroll
        for (int ai = 0; ai < 2; ++ai)
#pragma unroll
            for (int m = 0; m < 4; ++m) { float r = 0.f;
#pragma unroll
                for (int bj = 0; bj < 2; ++bj) r = amax4(amax4(r, acc[ai][bj][m][0]), acc[ai][bj][m][1]);
                r = fmaxf(r, __shfl_xor(r, 16)); r = fmaxf(r, __shfl_xor(r, 32));
                if (fq == 0) xl[((wr * 4 + wc) * 8 + ai * 4 + m) * 16 + fr] = r; }
        LDS_WAIT(); asm volatile("" ::: "memory"); __builtin_amdgcn_s_barrier(); asm volatile("" ::: "memory");
        if (wc == 0 && fq == 0) {
#pragma unroll
            for (int ai = 0; ai < 2; ++ai)
#pragma unroll
                for (int m = 0; m < 4; ++m) { float t = xl[((wr * 4 + 0) * 8 + ai * 4 + m) * 16 + fr];
#pragma unroll
                    for (int q = 1; q < 4; ++q) t = fmaxf(t, xl[((wr * 4 + q) * 8 + ai * 4 + m) * 16 + fr]);
                    __hip_atomic_store((unsigned*)(PM + (size_t)(u.pm * 256 + ai * 128 + wr * 64 + m * 16 + fr) * 8 + u.pn), __builtin_bit_cast(unsigned, t), RLX_AGENT); }
        }
        asm volatile("s_waitcnt vmcnt(0)" ::: "memory"); __builtin_amdgcn_s_barrier(); asm volatile("" ::: "memory");
        if (tid == 0) { unsigned* pc = PCNT + 64 * u.pm; __hip_atomic_fetch_add(pc, 1u, RLX_AGENT); unsigned sp = 0;
            while (ld_agent(pc) < 8u) { __builtin_amdgcn_s_sleep(1); if (++sp > (1u << 20)) break; } }
        asm volatile("" ::: "memory"); __builtin_amdgcn_s_barrier(); asm volatile("" ::: "memory");
        { const float* pr = PM + (size_t)(u.pm * 256 + (tid >> 1)) * 8 + 4 * (tid & 1);
          float v = fmaxf(fmaxf(ld_agent_f(pr), ld_agent_f(pr + 1)), fmaxf(ld_agent_f(pr + 2), ld_agent_f(pr + 3)));
          v = fmaxf(v, __shfl_xor(v, 1)); if ((tid & 1) == 0) xl[1024 + (tid >> 1)] = v; }
        LDS_WAIT(); asm volatile("" ::: "memory"); __builtin_amdgcn_s_barrier(); asm volatile("" ::: "memory");
#pragma unroll
        for (int ai = 0; ai < 2; ++ai)
#pragma unroll
            for (int m = 0; m < 4; ++m) { const int rl = ai * 128 + wr * 64 + m * 16 + fr, row = u.pm * 256 + rl;
                const float mx = xl[1024 + rl], sc = mx > 0.f ? 127.f / mx : 0.f;
                if (u.pn == 0 && wc == 0 && fq == 0) __hip_atomic_store((unsigned*)(RS + row), __builtin_bit_cast(unsigned, mx * (1.f / (127.f * SO8 * SWU8))), RLX_AGENT);
#pragma unroll
                for (int bj = 0; bj < 2; ++bj) { const f32x4 a = acc[ai][bj][m][0] * sc, b = acc[ai][bj][m][1] * sc;
                    u32x2 w; w.x = pki8(a[0], a[1], a[2], a[3]); w.y = pki8(b[0], b[1], b[2], b[3]);
                    __hip_atomic_store((unsigned long long*)(MG8 + (size_t)row * DM + col + 32 * bj), (unsigned long long)w.x | ((unsigned long long)w.y << 32), RLX_AGENT); } }
        asm volatile("s_waitcnt vmcnt(0)" ::: "memory"); __builtin_amdgcn_s_barrier(); asm volatile("" ::: "memory");
        if (tid == 0) __hip_atomic_fetch_add(PCNT + 64 * u.pm + 32, 1u, RLX_AGENT);
        return false;
    }
};

struct SchedOut8 {
    const char* A; const char* Bt; int G, c;
    __device__ __forceinline__ bool next(int i, g8::Unit& u) const {
        int pm, pn; if (!g8::tile_order(NTOK / 256, DM / 256, G, c, i, pm, pn)) return false;
        u.a = A + (size_t)pm * 256 * DM; u.b = Bt + (size_t)pn * 256 * DM; u.rows = nullptr; u.nkt = DM / 128; u.pm = pm; u.pn = pn; u.x0 = 0; u.x1 = 0; return true;
    }
};
struct EpiOut {
    const float* X; bf16_t* X1B; float* SS; unsigned char* X8; const float* RS; const float* WOSC;
    __device__ __forceinline__ bool operator()(f32x4 (&acc)[2][2][4][2], const g8::Unit& u, int wr, int wc, int fr, int fq) const {
        const int col = u.pn * 256 + wc * 64 + 8 * fq;
        const float w0 = ld_agent_f(WOSC + u.pn * 8 + wc * 2), w1 = ld_agent_f(WOSC + u.pn * 8 + wc * 2 + 1);
#pragma unroll
        for (int ai = 0; ai < 2; ++ai) {
            f32x4 xa[4][2], xb[4][2];
#pragma unroll
            for (int m = 0; m < 4; ++m)
#pragma unroll
                for (int bj = 0; bj < 2; ++bj) { const size_t off = (size_t)(u.pm * 256 + ai * 128 + wr * 64 + m * 16 + fr) * DM + col + 32 * bj; xa[m][bj] = NT_LD4(X + off); xb[m][bj] = NT_LD4(X + off + 4); }
#pragma unroll
            for (int m = 0; m < 4; ++m) { const int row = u.pm * 256 + ai * 128 + wr * 64 + m * 16 + fr; float s = 0.f; const float xr = ld_agent_f(RS + row);
#pragma unroll
                for (int bj = 0; bj < 2; ++bj) { const size_t off = (size_t)row * DM + col + 32 * bj; const float isc = xr * (bj ? w1 : w0);
                    const i32x4 ia = __builtin_bit_cast(i32x4, acc[ai][bj][m][0]), ib = __builtin_bit_cast(i32x4, acc[ai][bj][m][1]);
                    const f32x4 a = xa[m][bj] + (f32x4){(float)ia[0], (float)ia[1], (float)ia[2], (float)ia[3]} * isc, b = xb[m][bj] + (f32x4){(float)ib[0], (float)ib[1], (float)ib[2], (float)ib[3]} * isc;
                    s += (a[0] * a[0] + a[1] * a[1]) + (a[2] * a[2] + a[3] * a[3]) + (b[0] * b[0] + b[1] * b[1]) + (b[2] * b[2] + b[3] * b[3]);
                    u32x4 w; w.x = pk2(a[0], a[1]); w.y = pk2(a[2], a[3]); w.z = pk2(b[0], b[1]); w.w = pk2(b[2], b[3]);
                    *(GAS u32x4*)(X1B + off) = w;
                    u32x2 w8; w8.x = pk8(a[0] * SX8, a[1] * SX8, a[2] * SX8, a[3] * SX8); w8.y = pk8(b[0] * SX8, b[1] * SX8, b[2] * SX8, b[3] * SX8); *(GAS u32x2*)(X8 + off) = w8; }
                s += __shfl_xor(s, 16); s += __shfl_xor(s, 32);
                if (fq == 0) SS[(size_t)row * 32 + u.pn * 4 + wc] = s; }
        }
        return false;
    }
};

__device__ __forceinline__ void p5a_route(const Frame& F) {
    typedef float f32x16 __attribute__((ext_vector_type(16)));
    const bf16_t* X1B = (const bf16_t*)(F.ws + WS_XN); const float* SS = (const float*)(F.ws + WS_SS); const bf16_t* GWT = (const bf16_t*)(F.ws + WS_GWT);
    unsigned* TOS = (unsigned*)(F.ws + WS_SL + SL_TOS); float* WOS = (float*)(F.ws + WS_SL + SL_WOS); float* RSOS = (float*)(F.ws + WS_SL + SL_RSOS);
    unsigned* ECNT = (unsigned*)(F.ws + WS_CTL) + CW_ECNT; unsigned* BCNT = (unsigned*)(F.ws + WS_CTL) + CW_BCNT;
    unsigned* BTOK = (unsigned*)(F.ws + WS_BK + BK_TOK); unsigned* BRA = (unsigned*)(F.ws + WS_BK + BK_RA); unsigned* BRB = (unsigned*)(F.ws + WS_BK + BK_RB);
    LAS unsigned* le = (LAS unsigned*)(F.lds + LDS_X_OFF);
    LAS float* lw = (LAS float*)(le + 64); LAS float* lr = lw + 64; LAS unsigned* lb = (LAS unsigned*)(lr + 32);
    LAS unsigned* lk = lb + 16; LAS unsigned* lkb = lk + 32; LAS unsigned* lsl = lkb + 32;
    LAS float* PT = (LAS float*)F.lds;
    const int lane = F.lane, w = F.wave, r32 = lane & 31, hi = lane >> 5, tokb = F.vcu * 32;
    f32x16 acc;
#pragma unroll
    for (int r = 0; r < 16; ++r) acc[r] = 0.f;
    const bf16_t* xa = X1B + (size_t)(tokb + r32) * DM + 256 * w + 8 * hi; const bf16_t* gb = GWT + (size_t)r32 * DM + 256 * w + 8 * hi;
#pragma unroll 1
    for (int hb = 0; hb < 2; ++hb) {
        bf16x8 af[8], bfr[8];
#pragma unroll
        for (int i = 0; i < 8; ++i) { af[i] = *(const GAS bf16x8*)(xa + 128 * hb + 16 * i); bfr[i] = *(const GAS bf16x8*)(gb + 128 * hb + 16 * i); }
#pragma unroll
        for (int i = 0; i < 8; ++i) acc = __builtin_amdgcn_mfma_f32_32x32x16_bf16(af[i], bfr[i], acc, 0, 0, 0);
    }
#pragma unroll
    for (int r = 0; r < 16; ++r) PT[(w * 32 + ((r & 3) + 8 * (r >> 2) + 4 * hi)) * 32 + r32] = acc[r];
    LDS_WAIT(); __syncthreads();
    LAS float* LG = PT + 8192;
#pragma unroll
    for (int i = 0; i < 2; ++i) { const int o = F.tid + 512 * i; float v = 0.f;
#pragma unroll
        for (int ww = 0; ww < 8; ++ww) v += PT[ww * 1024 + o];
        LG[o] = v; }
    LDS_WAIT(); __syncthreads();
    if (F.tid < 32) {
        const int lt = F.tid, tok = tokb + lt; float ss = 0.f;
#pragma unroll
        for (int j = 0; j < 8; ++j) { const f32x4 p = ((const GAS f32x4*)(SS + (size_t)tok * 32))[j]; ss += (p.x + p.y) + (p.z + p.w); }
        const float rstd = 1.0f / sqrtf(ss * (1.f / DM) + EPS);
        float lgp[4], el[4];
#pragma unroll
        for (int c = 0; c < 4; ++c) lgp[c] = LG[lt * 32 + c] * rstd;
        int gi = 0; float gm = lgp[0];
#pragma unroll
        for (int c = 1; c < 4; ++c) if (lgp[c] > gm) { gm = lgp[c]; gi = c; }
        float gden = 0.f;
#pragma unroll
        for (int c = 0; c < 4; ++c) gden += __expf(lgp[c] - gm);
        const float g_p = 1.0f / gden;
#pragma unroll
        for (int c = 0; c < 4; ++c) el[c] = LG[lt * 32 + 4 + 4 * gi + c] * rstd;
        int e1 = 0; float m1 = el[0];
#pragma unroll
        for (int c = 1; c < 4; ++c) if (el[c] > m1) { m1 = el[c]; e1 = c; }
        int e2 = -1; float m2 = -INFINITY;
#pragma unroll
        for (int c = 0; c < 4; ++c) if (c != e1 && el[c] > m2) { m2 = el[c]; e2 = c; }
        const float w1 = g_p / (1.0f + __expf(m2 - m1)), w2 = g_p / (1.0f + __expf(m1 - m2));
        le[2 * lt] = (unsigned)(gi * 4 + e1); le[2 * lt + 1] = (unsigned)(gi * 4 + e2); lw[2 * lt] = w1; lw[2 * lt + 1] = w2; lr[lt] = rstd;
        const int ea = e1 < e2 ? e1 : e2, eb = e1 < e2 ? e2 : e1;
        lk[lt] = (unsigned)(gi * 6 + ((ea * (7 - ea)) >> 1) + (eb - ea - 1)) | (e1 > e2 ? 64u : 0u);
    }
    LDS_WAIT(); __syncthreads();
    if (F.tid < NEXP) { unsigned c = 0; for (int i = 0; i < 64; ++i) c += (le[i] == (unsigned)F.tid) ? 1u : 0u; lb[F.tid] = c ? __hip_atomic_fetch_add(ECNT + F.tid, c, RLX_AGENT) : 0u; }
    else if (F.tid >= 64 && F.tid < 64 + NBK) { const unsigned b = (unsigned)(F.tid - 64); unsigned c = 0; for (int i = 0; i < 32; ++i) c += ((lk[i] & 63u) == b) ? 1u : 0u; lkb[b] = c ? __hip_atomic_fetch_add(BCNT + b, c, RLX_AGENT) : 0u; }
    LDS_WAIT(); __syncthreads();
    if (F.tid < 64) { const int a = F.tid; const unsigned e = le[a]; unsigned rank = 0;
        for (int i = 0; i < a; ++i) rank += (le[i] == e) ? 1u : 0u;
        const unsigned slot = e * ECAP + lb[e] + rank; const int tok = F.vcu * 32 + (a >> 1);
        TOS[slot] = (unsigned)tok; WOS[slot] = lw[a]; RSOS[slot] = lr[a >> 1]; lsl[a] = slot; }
    LDS_WAIT(); __syncthreads();
    if (F.tid < 32) { const int lt = F.tid; const unsigned kk = lk[lt], b = kk & 63u, sw = kk >> 6; unsigned rank = 0;
        for (int i = 0; i < lt; ++i) rank += ((lk[i] & 63u) == b) ? 1u : 0u;
        const unsigned bs = b * BCAP + lkb[b] + rank;
        BTOK[bs] = (unsigned)(tokb + lt); BRA[bs] = lsl[2 * lt + (int)sw]; BRB[bs] = lsl[2 * lt + 1 - (int)sw]; }
    __syncthreads();
}
struct MoeInfo { unsigned mt0[NEXP + 1]; };
__device__ __forceinline__ int moe_expert_of(const LAS unsigned* mt0, int mtile) { int e = 0;
#pragma unroll
    for (int q = 1; q < NEXP; ++q) if ((unsigned)mtile >= mt0[q]) e = q; return e; }
struct SchedMoeUp {
    const char* H2; const char* Wgu; const int* TOS; const LAS unsigned* mt0; int G, c; bool split;
    __device__ __forceinline__ bool next(int i, g8::Unit& u) const {
        const int nun = (int)mt0[NEXP] * 4; int L = i * G + c, hs = 0, hf = 0;
        if (split && i >= 1) {
            if (i > 1) return false; const int R = nun - G; if (c >= 2 * R) return false; L = G + (c >> 1); hs = c & 1; hf = 1; }
        if (L >= nun) return false;
        const int mtile = L >> 2, nt = L & 3, e = moe_expert_of(mt0, mtile), sb = e * ECAP + (mtile - (int)mt0[e]) * 256 + 128 * hs;
        u.a = H2; u.rows = TOS + sb; u.b = Wgu + ((size_t)e * 1024 + (size_t)nt * 256) * DM; u.nkt = DM / 128; u.pm = mtile; u.pn = nt; u.x0 = e; u.x1 = sb; u.half = hf; return true;
    }
};
struct EpiMoeUp {
    const float* WOS; const float* RSOS; bf16_t* HID;
    __device__ __forceinline__ bool operator()(f32x4 (&acc)[2][2][4][2], const g8::Unit& u, int wr, int wc, int fr, int fq) const {
        const int col = u.pn * 128 + wc * 32 + 8 * fq;
        float wv[2][4], rv[2][4];
#pragma unroll
        for (int ai = 0; ai < 2; ++ai)
#pragma unroll
            for (int m = 0; m < 4; ++m) { const int slot = u.x1 + ai * 128 + wr * 64 + m * 16 + fr; wv[ai][m] = WOS[slot]; rv[ai][m] = RSOS[slot] * (1.0f / (SX8 * SW8)); }
#pragma unroll
        for (int ai = 0; ai < 2; ++ai)
#pragma unroll
            for (int m = 0; m < 4; ++m) { const int slot = u.x1 + ai * 128 + wr * 64 + m * 16 + fr; const float w = wv[ai][m], rs = rv[ai][m];
                float hv[8];
#pragma unroll
                for (int n = 0; n < 2; ++n)
#pragma unroll
                    for (int i = 0; i < 4; ++i) { const float g = acc[ai][0][m][n][i] * rs, up = acc[ai][1][m][n][i] * rs;
                        hv[4 * n + i] = g * __builtin_amdgcn_rcpf(1.0f + __builtin_amdgcn_exp2f(-g * LOG2E)) * up * w; }
#pragma unroll
                for (int q = 0; q < 8; ++q) hv[q] = fminf(fmaxf(hv[q] * SH8, -448.f), 448.f);
                u32x2 o; o.x = pk8(hv[0], hv[1], hv[2], hv[3]); o.y = pk8(hv[4], hv[5], hv[6], hv[7]);
                if (!(u.half && ai == 1)) *(GAS u32x2*)((unsigned char*)HID + (size_t)slot * DEXP + col) = o; }
        return false;
    }
};
__device__ __forceinline__ int moe_bucket_of(const LAS unsigned* bt0, int mtile) { int b = 0;
#pragma unroll
    for (int q = 1; q < NBK; ++q) if ((unsigned)mtile >= bt0[q]) b = q; return b; }
struct SchedMoeDown {
    const char* HID; const char* Wd; const int* BRA; const int* BRB; const LAS unsigned* bt0; int G, c; bool split;
    __device__ __forceinline__ bool next(int i, g8::Unit& u) const {
        const int h = i & 1; int L = (i >> 1) * G + c, hs = 0, hf = 0; const int nun = (int)bt0[NBK] * 8;
        if (split && (i >> 1) >= 1) {
            if ((i >> 1) > 1) return false; const int R = nun - G; if (c >= 2 * R) return false; L = G + (c >> 1); hs = c & 1; hf = 1; }
        if (L >= nun) return false;
        const int mtile = L >> 3, pn = L & 7, b = moe_bucket_of(bt0, mtile), lt = mtile - (int)bt0[b], sb = b * BCAP + lt * 256 + 128 * hs;
        const int g = b / 6, p = b - g * 6, e = g * 4 + (int)(((h ? 0xFB9u : 0x940u) >> (2 * p)) & 3u);
        int lim = (int)bt0[64 + b] - lt * 256 - 128 * hs; lim = lim > (hf ? 128 : 256) ? (hf ? 128 : 256) : lim; lim = lim < 0 ? 0 : lim;
        u.a = HID; u.rows = (h ? BRB : BRA) + sb; u.b = Wd + ((size_t)e * DM + (size_t)pn * 256) * DEXP; u.nkt = DEXP / 128; u.pm = mtile; u.pn = pn; u.x0 = h | (lim << 1); u.x1 = sb; u.half = hf; return true;
    }
};
struct EpiMoeDown {
    float* out; const bf16_t* X1B; const unsigned* BTOK;
    __device__ __forceinline__ bool operator()(f32x4 (&acc)[2][2][4][2], const g8::Unit& u, int wr, int wc, int fr, int fq) const {
        if ((u.x0 & 1) == 0) return true;
        const int lim = u.x0 >> 1, col = u.pn * 256 + wc * 64 + 8 * fq; constexpr float isc = 1.0f / (SH8 * SD8);
#pragma unroll
        for (int ai = 0; ai < 2; ++ai) {
            unsigned tk[4]; u32x4 xv[4][2];
#pragma unroll
            for (int m = 0; m < 4; ++m) { const int r = ai * 128 + wr * 64 + m * 16 + fr; tk[m] = BTOK[u.x1 + r]; }
#pragma unroll
            for (int m = 0; m < 4; ++m)
#pragma unroll
                for (int bj = 0; bj < 2; ++bj) xv[m][bj] = NT_LDU4(X1B + (size_t)tk[m] * DM + col + 32 * bj);
#pragma unroll
            for (int m = 0; m < 4; ++m) { const int r = ai * 128 + wr * 64 + m * 16 + fr;
                if (r < lim) {
#pragma unroll
                    for (int bj = 0; bj < 2; ++bj) { const u32x4 x = xv[m][bj]; const f32x4 a = acc[ai][bj][m][0], b = acc[ai][bj][m][1];
                        f32x4 o0, o1; o0[0] = bf_lo(x.x) + a[0] * isc; o0[1] = bf_hi(x.x) + a[1] * isc; o0[2] = bf_lo(x.y) + a[2] * isc; o0[3] = bf_hi(x.y) + a[3] * isc;
                        o1[0] = bf_lo(x.z) + b[0] * isc; o1[1] = bf_hi(x.z) + b[1] * isc; o1[2] = bf_lo(x.w) + b[2] * isc; o1[3] = bf_hi(x.w) + b[3] * isc;
                        GAS f32x4* op = (GAS f32x4*)(out + (size_t)tk[m] * DM + col + 32 * bj); __builtin_nontemporal_store(o0, op); __builtin_nontemporal_store(o1, op + 1); } } }
        }
        return false;
    }
};
__device__ __forceinline__ void moe_load_buckets(const Frame& F, LAS unsigned* bt0) {
    const unsigned* BCNT = (const unsigned*)(F.ws + WS_CTL) + CW_BCNT;
    if (F.tid < NBK) { const unsigned c = ld_agent(BCNT + F.tid); bt0[64 + F.tid] = c; bt0[32 + F.tid] = (c + 255u) >> 8; }
    LDS_WAIT(); __syncthreads();
    if (F.tid == 0) { unsigned s = 0; for (int b = 0; b < NBK; ++b) { bt0[b] = s; s += bt0[32 + b]; } bt0[NBK] = s; }
    LDS_WAIT(); __syncthreads();
}
__device__ __forceinline__ void moe_load_info(const Frame& F, LAS unsigned* mt0) {
    const unsigned* ECNT = (const unsigned*)(F.ws + WS_CTL) + CW_ECNT;
    if (F.tid < NEXP) mt0[32 + F.tid] = (ld_agent(ECNT + F.tid) + 255u) >> 8;
    LDS_WAIT(); __syncthreads();
    if (F.tid == 0) { unsigned s = 0; for (int e = 0; e < NEXP; ++e) { mt0[e] = s; s += mt0[32 + e]; } mt0[NEXP] = s; }
    LDS_WAIT(); __syncthreads();
}

constexpr int N_PHASES = 9;
__global__ void __launch_bounds__(NWAVES * 64, 2) fwd(Args args) {
    extern __shared__ __attribute__((aligned(16))) unsigned char lds[];
    Frame F;
    F.lds = (LAS unsigned char*)lds;
    F.tid = threadIdx.x; F.lane = F.tid & 63; F.wave = __builtin_amdgcn_readfirstlane(F.tid >> 6);
    F.G = gridDim.x; { const int bx = blockIdx.x; F.vcu = (F.G % 8 == 0) ? (bx % 8) * (F.G / 8) + bx / 8 : bx; }
    F.x = args.in[0]; F.g_mix = args.in[1]; F.w_in = args.in[2]; F.qn_a = args.in[3]; F.kn_a = args.in[4]; F.sinks = args.in[5]; F.qn_b = args.in[6]; F.kn_b = args.in[7];
    F.w_upa = args.in[8]; F.w_upb = args.in[9]; F.w_out = args.in[10]; F.g_ffn = args.in[11]; F.w_rg = args.in[12]; F.w_re = args.in[13]; F.w_ge = args.in[14]; F.w_ue = args.in[15]; F.w_de = args.in[16];
    F.out = args.out; F.ws = args.ws;
    volatile LAS unsigned* MISC = (volatile LAS unsigned*)(F.lds + MISC_OFF);
    for (int u = F.tid; u < (LDS_X_OFF - LDSCTL_OFF) / 4; u += NWAVES * 64) ((LAS unsigned*)(F.lds + LDSCTL_OFF))[u] = 0u;
    __syncthreads();
    gu32* ctl = (gu32*)(F.ws + WS_CTL);
    XcdBarrier bar; bar.bar = (unsigned*)(ctl + CW_BAR); bar.x = 0; bar.st = nullptr;
    const int lo = args.ph_lo, hi = args.ph_hi;
    const bool multi = (hi - lo) > 1;
    if (multi) bar = xcd_barrier_post((unsigned*)(ctl + CW_BAR), MISC + 8);
#define IN(k) (lo <= (k) && (k) < hi)
#define SEAM(k) do { if (IN(k) && IN((k) + 1)) xcd_barrier(bar); } while (0)
    const int cid = (int)blockIdx.x;
    const int GG = (F.G == 256) ? 216 : F.G;

    if (IN(0)) { p0_prologue(F); if (F.G != 256) convert_up_out_blocks(F, F.vcu, F.G);     SEAM(0); }
    if (IN(1)) {
        if (cid < GG) { SchedIn8 S{(const char*)(F.ws + WS_X8), (const char*)(F.ws + WS_WIN8), GG, cid};
          const float* XS = (const float*)(F.ws + WS_XS); const float* WSC = (const float*)(F.ws + WS_WSC);
          EpiIn8 E{EpiProj{(bf16_t*)(F.ws + WS_PROJ), (float*)(F.ws + WS_KSUM), F.qn_a, F.kn_a, F.qn_b, F.kn_b, XS, WSC}, EpiGate8{(bf16_t*)(F.ws + WS_PROJ), XS, WSC}};
          g8::gemm_phase<EpiIn8, SchedIn8, false, false, true>(F.lds, DM / 2, DM / 2, S, E);
          if (F.G == 256 && cid >= 192) convert_moe_gate_up(F, 440 + (cid - 192), 24); }
        else { convert_up_out_blocks(F, cid - GG, F.G - GG); convert_moe_gate_up(F, cid - GG, F.G - GG, F.G == 256 ? 440 : 512); }
        if (GG == F.G) convert_moe_gate_up(F, cid, F.G);
        SEAM(1);
    }
    #if defined(ATTN_NAIVE)
    if (IN(2)) { attn_naive(F); SEAM(2); }
#else
    if (IN(2)) { att::attn_phase(F); SEAM(2); }
#endif
    if (IN(3)) {
        SchedUp S{(const char*)(F.ws + WS_OCAT), (const char*)(F.ws + WS_WUP), F.G, cid};
        EpiUp E{(const bf16_t*)(F.ws + WS_PROJ), F.ws + WS_MERGED, (float*)(F.ws + WS_PM), (float*)(F.ws + WS_RS), (unsigned*)(F.ws + WS_CTL) + CW_PCNT, (LAS float*)(F.lds + LDS_X_OFF)};
        g8::gemm_phase<EpiUp, SchedUp, false, true>(F.lds, 512, 512, S, E);
        if (IN(3) && IN(4)) {
            int pm, pn; (void)g8::tile_order(32, 8, F.G, cid, 0, pm, pn);
            if (F.tid == 0) { const unsigned* pc = (const unsigned*)(F.ws + WS_CTL) + CW_PCNT + 64 * pm + 32; unsigned sp = 0;
                while (ld_agent(pc) < 8u) { __builtin_amdgcn_s_sleep(1); if (++sp > (1u << 20)) break; }
                __builtin_amdgcn_fence(__ATOMIC_ACQUIRE, "agent"); asm volatile("s_waitcnt vmcnt(0)" ::: "memory"); }
            __syncthreads(); }
    }
    if (IN(4)) {
        SchedOut8 S{(const char*)(F.ws + WS_MERGED), (const char*)(F.ws + WS_WOUT), F.G, cid};
        EpiOut E{F.x, (bf16_t*)(F.ws + WS_XN), (float*)(F.ws + WS_SS), (unsigned char*)(F.ws + WS_X8), (const float*)(F.ws + WS_RS), (const float*)(F.ws + WS_WOSC)};
        g8::gemm_phase<EpiOut, SchedOut8, false, false, true>(F.lds, DM / 2, DM / 2, S, E);
        SEAM(4);
    }
    if (IN(5)) { p5a_route(F); if (IN(5) && IN(7)) xcd_barrier(bar); }
    LAS unsigned* mt0 = (LAS unsigned*)(F.lds + LDS_X_OFF + 1024);
    if (IN(7)) {
        moe_load_info(F, mt0);
        SchedMoeUp S{(const char*)(F.ws + WS_X8), (const char*)(F.ws + WS_WGU), (const int*)(F.ws + WS_SL + SL_TOS), mt0, GG, (F.G == 256) ? (cid & 7) * (GG / 8) + (cid >> 3) : F.vcu, F.G == 256};
        EpiMoeUp E{(const float*)(F.ws + WS_SL + SL_WOS), (const float*)(F.ws + WS_SL + SL_RSOS), (bf16_t*)(F.ws + WS_PROJ)};
        if (cid < GG) g8::gemm_phase<EpiMoeUp, SchedMoeUp, true, true, false, true>(F.lds, DM / 2, DM / 2, S, E);
        else convert_moe_down(F, cid - GG, F.G - GG);
        if (GG == F.G) convert_moe_down(F, cid, F.G);
        SEAM(7);
    }
    if (IN(8)) {
        LAS unsigned* bt0 = mt0 + 128;
        moe_load_buckets(F, bt0);
        SchedMoeDown S{(const char*)(F.ws + WS_PROJ), (const char*)(F.ws + WS_WD), (const int*)(F.ws + WS_BK + BK_RA), (const int*)(F.ws + WS_BK + BK_RB), bt0, F.G, F.vcu, F.G == 256};
        EpiMoeDown E{F.out, (const bf16_t*)(F.ws + WS_XN), (const unsigned*)(F.ws + WS_BK + BK_TOK)};
        g8::gemm_phase<EpiMoeDown, SchedMoeDown, true, true, false, true>(F.lds, DEXP / 2, DEXP / 2, S, E);
    }
#undef IN
#undef SEAM
}

extern "C" void kernel_launch(void* const* d_in, const int* in_sizes, int n_in, void* d_out, int out_size, void* d_ws, size_t ws_size, hipStream_t stream) {
    static int grid = 0;
    if (grid == 0) {
        if (n_in != 17 || in_sizes[0] != NTOK * DM || out_size != NTOK * DM || ws_size < WS_END) {
            fprintf(stderr, "kernel_launch: unexpected problem (n_in %d, in0 %d, out %d, ws %zu)\n", n_in, n_in > 0 ? in_sizes[0] : -1, out_size, ws_size); grid = -1; return; }
        int dev = 0, cus = 0, per_cu = 0;
        if (hipGetDevice(&dev) != hipSuccess || hipDeviceGetAttribute(&cus, hipDeviceAttributeMultiprocessorCount, dev) != hipSuccess) { grid = -1; return; }
        if (hipFuncSetAttribute((const void*)fwd, hipFuncAttributeMaxDynamicSharedMemorySize, LDS_BYTES) != hipSuccess) { fprintf(stderr, "kernel_launch: hipFuncSetAttribute failed\n"); grid = -1; return; }
        if (hipOccupancyMaxActiveBlocksPerMultiprocessor(&per_cu, (const void*)fwd, NWAVES * 64, LDS_BYTES) != hipSuccess || per_cu < 1)
            fprintf(stderr, "kernel_launch: occupancy query reports %d workgroups per CU\n", per_cu);
        (void)hipGetLastError();
        grid = cus;
        if (grid != 256) fprintf(stderr, "kernel_launch: %d CUs (built for 256)\n", grid);
    }
    if (grid < 0) return;
    (void)hipMemsetAsync((char*)d_ws + WS_CTL, 0, CTL_ZERO_BYTES, stream);
    Args a{};
    for (int i = 0; i < 17; ++i) a.in[i] = (const float*)d_in[i];
    a.out = (float*)d_out; a.ws = (unsigned char*)d_ws;
#if MK_LAUNCHES == 1
    a.ph_lo = 0; a.ph_hi = N_PHASES;
    hipLaunchKernelGGL(fwd, dim3(grid), dim3(NWAVES * 64), LDS_BYTES, stream, a);
#else
#ifndef PROBE_REP_MASK
#define PROBE_REP_MASK 0
#endif
    for (int p = 0; p < N_PHASES; ++p) { if (p == 6) continue; a.ph_lo = p; a.ph_hi = p + 1;
        for (int rep = 0; rep < 1 + ((PROBE_REP_MASK >> p) & 1); ++rep) hipLaunchKernelGGL(fwd, dim3(grid), dim3(NWAVES * 64), LDS_BYTES, stream, a); }
#endif
}
```
